# Optimizing an MI355X kernel written in HIP

```python
import jax, jax.numpy as jnp
from jax import lax
import numpy as np

D_MODEL = 1024
BATCH = 16
SEQ = 2048
DEPTH = 1

GRID_W = 64
CTX_LEN = 256
MIX_WIDTH = D_MODEL
POOL_WIDTH = MIX_WIDTH // 2
POOL_WINDOWS = (2, 4, 8, 16)
POOL_GROUP = POOL_WIDTH // len(POOL_WINDOWS)
MLA_HEADS = 8
QK_NOPE = 64
QK_ROPE = 32
QK_HEAD = QK_NOPE + QK_ROPE
V_HEAD = 64
Q_LORA = 384
KV_LORA = 256
ROPE_THETA = 10000.0
ATTN_BLOCK = 128
IN_WIDTH = POOL_WIDTH + Q_LORA + KV_LORA + QK_ROPE
PEER_HEADS = 8
PEER_N_KEYS = 128
PEER_N_EXPERTS = PEER_N_KEYS * PEER_N_KEYS
PEER_QUERY_DIM = 256
PEER_HALF = PEER_QUERY_DIM // 2
PEER_TOPK = 16
PEER_BLOCK = 128
EPS = 1e-6

kernel_name = "hymba_pool_mla_peer_dit_layer"


def rms_norm(x, g):
    xf = x.astype(jnp.float32)
    y = xf * lax.rsqrt(jnp.mean(xf * xf, axis=-1, keepdims=True) + EPS)
    return (y * g.astype(jnp.float32)).astype(x.dtype)


def modulate(h, shift, scale):
    return h * (1.0 + scale[..., None, :]) + shift[..., None, :]


def axial_rope_tables(n_tokens):
    rows = n_tokens // GRID_W
    row = jnp.repeat(jnp.arange(rows), GRID_W).astype(jnp.float32)
    col = jnp.tile(jnp.arange(GRID_W), rows).astype(jnp.float32)
    n = QK_ROPE // 4
    inv = 1.0 / (ROPE_THETA ** (jnp.arange(n, dtype=jnp.float32) / n))
    ang_r = row[:, None] * inv
    ang_c = col[:, None] * inv
    ang = jnp.concatenate([ang_r, ang_r, ang_c, ang_c], axis=-1)
    return jnp.cos(ang), jnp.sin(ang)


def apply_rope(t, cos, sin):
    nope, rope = t[..., :QK_NOPE], t[..., QK_NOPE:]
    n = QK_ROPE // 4
    r = rope.reshape(rope.shape[:-1] + (2, 2, n))
    rot = jnp.stack([-r[..., 1, :], r[..., 0, :]], axis=-2).reshape(rope.shape)
    rope = rope * cos[:, None, :] + rot * sin[:, None, :]
    return jnp.concatenate([nope, rope.astype(t.dtype)], axis=-1)


def multiscale_pool(p, pool_w, pool_scale):
    B, L, C = p.shape
    pf = p.astype(jnp.float32)
    cs = jnp.concatenate([jnp.zeros((B, 1, C), jnp.float32), jnp.cumsum(pf, axis=1)], axis=1)
    t = jnp.arange(L)
    outs = []
    for g, w in enumerate(POOL_WINDOWS):
        lo = jnp.clip(t - w // 2, 0, L)
        hi = jnp.clip(t + w // 2, 0, L)
        sl = slice(g * POOL_GROUP, (g + 1) * POOL_GROUP)
        csg = cs[..., sl]
        mean = (jnp.take(csg, hi, axis=1) - jnp.take(csg, lo, axis=1)) / (hi - lo).astype(jnp.float32)[:, None]
        outs.append(jnp.einsum('blc,cd->bld', mean - pf[..., sl], pool_w[g].astype(jnp.float32)))
    y = jnp.concatenate(outs, axis=-1) * pool_scale.astype(jnp.float32)
    return y.astype(p.dtype)


def mla_keys_values(ckv, kr, g_kv_lora, w_kv_up, g_qk_k):
    B, L, _ = ckv.shape
    kv = (rms_norm(ckv, g_kv_lora) @ w_kv_up).reshape(B, L, MLA_HEADS, QK_NOPE + V_HEAD)
    k_nope, v = kv[..., :QK_NOPE], kv[..., QK_NOPE:]
    k = jnp.concatenate([k_nope, jnp.broadcast_to(kr[:, :, None, :], (B, L, MLA_HEADS, QK_ROPE))], axis=-1)
    return rms_norm(k, g_qk_k), v


def block_attention(q, k_all, v_all):
    B, S, H, _ = q.shape
    nb = S // ATTN_BLOCK
    qb = q.reshape(B, nb, ATTN_BLOCK, H, QK_HEAD).transpose(1, 0, 3, 2, 4)
    kt = k_all.transpose(0, 2, 1, 3)
    vt = v_all.transpose(0, 2, 1, 3)
    scale = 1.0 / np.sqrt(QK_HEAD)

    def one_block(qblk):
        s = jnp.einsum('bhqd,bhkd->bhqk', qblk, kt).astype(jnp.float32) * scale
        pr = jax.nn.softmax(s, axis=-1)
        return jnp.einsum('bhqk,bhkd->bhqd', pr.astype(vt.dtype), vt)

    o = lax.map(one_block, qb)
    return o.transpose(1, 0, 3, 2, 4).reshape(B, S, H * V_HEAD)


def peer_ffn(h, peer_w_q, peer_sub_keys, peer_u, peer_v):
    B, L, D = h.shape
    qp = (h @ peer_w_q).reshape(B, L, PEER_HEADS, 2, PEER_HALF)
    s_half = jnp.einsum('blhpd,pnd->blhpn', qp, peer_sub_keys).astype(jnp.float32)
    v1, i1 = lax.top_k(s_half[..., 0, :], PEER_TOPK)
    v2, i2 = lax.top_k(s_half[..., 1, :], PEER_TOPK)
    cand = (v1[..., :, None] + v2[..., None, :]).reshape(B, L, PEER_HEADS, PEER_TOPK * PEER_TOPK)
    cidx = (i1[..., :, None] * PEER_N_KEYS + i2[..., None, :]).reshape(B, L, PEER_HEADS, PEER_TOPK * PEER_TOPK)
    top, pos = lax.top_k(cand, PEER_TOPK)
    eidx = jnp.take_along_axis(cidx, pos, axis=-1)
    gates = jax.nn.softmax(top, axis=-1)
    T = B * L
    nblk = T // PEER_BLOCK
    xt = h.reshape(nblk, PEER_BLOCK, D)
    et = eidx.reshape(nblk, PEER_BLOCK, PEER_HEADS * PEER_TOPK)
    gt = gates.reshape(nblk, PEER_BLOCK, PEER_HEADS * PEER_TOPK)

    def expert_block(args):
        xb, eb, gb = args
        u = jnp.take(peer_u, eb, axis=0)
        vv = jnp.take(peer_v, eb, axis=0)
        a = jax.nn.gelu(jnp.einsum('td,ted->te', xb, u).astype(jnp.float32), approximate=False)
        return jnp.einsum('te,ted->td', (gb * a).astype(xb.dtype), vv)

    y = lax.map(expert_block, (xt, et, gt))
    return y.reshape(B, L, D)


def setup_inputs(seed: int = 0) -> dict:
    key = jax.random.key(seed)
    ks = jax.random.split(key, 22)
    f = jnp.float32
    nrm = lambda k, shape, s: jax.random.normal(k, shape, f) * s
    return {
        "x": nrm(ks[0], (BATCH, SEQ, D_MODEL), 1.0),
        "c": nrm(ks[1], (BATCH, D_MODEL), 1.0),
        "ctx": nrm(ks[2], (BATCH, CTX_LEN, D_MODEL), 1.0),
        "c_ctx": nrm(ks[3], (D_MODEL,), 1.0),
        "w_ada": nrm(ks[4], (D_MODEL, 6 * D_MODEL), 0.5 * D_MODEL ** -0.5),
        "b_ada": nrm(ks[5], (6 * D_MODEL,), 0.02),
        "g_norm1": 1.0 + nrm(ks[6], (D_MODEL,), 0.02),
        "w_in": nrm(ks[7], (D_MODEL, IN_WIDTH), D_MODEL ** -0.5),
        "pool_w": nrm(ks[8], (len(POOL_WINDOWS), POOL_GROUP, POOL_GROUP), POOL_GROUP ** -0.5),
        "pool_scale": 1.0 + nrm(ks[9], (POOL_WIDTH,), 0.1),
        "g_q_lora": 1.0 + nrm(ks[10], (Q_LORA,), 0.02),
        "w_q_up": nrm(ks[11], (Q_LORA, MLA_HEADS * QK_HEAD), Q_LORA ** -0.5),
        "g_kv_lora": 1.0 + nrm(ks[12], (KV_LORA,), 0.02),
        "w_kv_up": nrm(ks[13], (KV_LORA, MLA_HEADS * (QK_NOPE + V_HEAD)), KV_LORA ** -0.5),
        "g_qk_q": 1.0 + nrm(ks[14], (QK_HEAD,), 0.02),
        "g_qk_k": 1.0 + nrm(ks[15], (QK_HEAD,), 0.02),
        "w_out": nrm(ks[16], (MIX_WIDTH, D_MODEL), MIX_WIDTH ** -0.5),
        "g_norm2": 1.0 + nrm(ks[17], (D_MODEL,), 0.02),
        "peer_w_q": nrm(ks[18], (D_MODEL, PEER_HEADS * PEER_QUERY_DIM), D_MODEL ** -0.5),
        "peer_sub_keys": nrm(ks[19], (2, PEER_N_KEYS, PEER_HALF), PEER_HALF ** -0.5),
        "peer_u": nrm(ks[20], (PEER_N_EXPERTS, D_MODEL), D_MODEL ** -0.5),
        "peer_v": nrm(ks[21], (PEER_N_EXPERTS, D_MODEL), 0.5),
    }


def hybrid_layer(x, c, ctx, c_ctx, w_ada, b_ada, g_norm1, w_in, pool_w, pool_scale,
                 g_q_lora, w_q_up, g_kv_lora, w_kv_up, g_qk_q, g_qk_k, w_out,
                 g_norm2, peer_w_q, peer_sub_keys, peer_u, peer_v):
    B, S, D = x.shape
    mod = jax.nn.silu(c) @ w_ada + b_ada
    shift1, scale1, gate1, shift2, scale2, gate2 = jnp.split(mod, 6, axis=-1)
    mod_ctx = jax.nn.silu(c_ctx) @ w_ada[:, :2 * D] + b_ada[:2 * D]
    shift1_c, scale1_c = mod_ctx[:D], mod_ctx[D:]

    h1 = modulate(rms_norm(x, g_norm1), shift1, scale1)
    proj = h1 @ w_in
    o1 = POOL_WIDTH
    o2 = o1 + Q_LORA
    o3 = o2 + KV_LORA
    p_in, cq, ckv, kr = proj[..., :o1], proj[..., o1:o2], proj[..., o2:o3], proj[..., o3:]

    pool_out = multiscale_pool(p_in, pool_w, pool_scale)

    cos, sin = axial_rope_tables(S)
    q = (rms_norm(cq, g_q_lora) @ w_q_up).reshape(B, S, MLA_HEADS, QK_HEAD)
    q = apply_rope(rms_norm(q, g_qk_q), cos, sin)
    k_lat, v_lat = mla_keys_values(ckv, kr, g_kv_lora, w_kv_up, g_qk_k)
    k_lat = apply_rope(k_lat, cos, sin)
    hc = modulate(rms_norm(ctx, g_norm1), shift1_c, scale1_c)
    projc = hc @ w_in[:, o2:]
    k_ctx, v_ctx = mla_keys_values(projc[..., :KV_LORA], projc[..., KV_LORA:], g_kv_lora, w_kv_up, g_qk_k)
    k_all = jnp.concatenate([k_lat, k_ctx], axis=1)
    v_all = jnp.concatenate([v_lat, v_ctx], axis=1)
    mla_out = block_attention(q, k_all, v_all)

    mix = jnp.concatenate([pool_out, mla_out], axis=-1) @ w_out
    x = x + gate1[:, None, :] * mix

    h2 = modulate(rms_norm(x, g_norm2), shift2, scale2)
    x = x + gate2[:, None, :] * peer_ffn(h2, peer_w_q, peer_sub_keys, peer_u, peer_v)
    return x


def reference(x, c, ctx, c_ctx, w_ada, b_ada, g_norm1, w_in, pool_w, pool_scale,
              g_q_lora, w_q_up, g_kv_lora, w_kv_up, g_qk_q, g_qk_k, w_out,
              g_norm2, peer_w_q, peer_sub_keys, peer_u, peer_v):
    for _ in range(DEPTH):
        x = hybrid_layer(x, c, ctx, c_ctx, w_ada, b_ada, g_norm1, w_in, pool_w, pool_scale,
                         g_q_lora, w_q_up, g_kv_lora, w_kv_up, g_qk_q, g_qk_k, w_out,
                         g_norm2, peer_w_q, peer_sub_keys, peer_u, peer_v)
    return x
```

```cpp
#include <hip/hip_runtime.h>
#include <stdint.h>
#include <math.h>

typedef unsigned short bf16_t;

constexpr int D = 1024, NB = 16, S = 2048, T = NB * S, CTXL = 256, TC = NB * CTXL, TA = T + TC;
constexpr int INW = 1184, PW = 512, QL = 384, KVL = 256, ROPE = 32, NOPE = 64, QKH = 96, VH = 64, NH = 8;
constexpr int SKV = S + CTXL;
constexpr int PLD = 1280;
constexpr int O_CQ = 512, O_CKV = 896, O_KR = 1152;
constexpr int PEH = 8, PEK = 128, PETOP = 16, PEQ = 256;
constexpr float EPS = 1e-6f;

constexpr size_t MB = 1024 * 1024;
constexpr size_t WS_MOD = 0;
constexpr size_t WS_ROPE = 512 * 1024;
constexpr size_t WS_H1 = 1 * MB;
constexpr size_t SZ_H1 = (size_t)TA * 1024 * 2;
constexpr size_t WS_PROJ = WS_H1 + SZ_H1;
constexpr size_t SZ_PROJ = (size_t)TA * PLD * 2;
constexpr size_t WS_PM = WS_PROJ + SZ_PROJ;
constexpr size_t SZ_PM = (size_t)T * 512 * 2;
constexpr size_t WS_CQN = WS_PM + SZ_PM;
constexpr size_t SZ_CQN = (size_t)T * 384 * 2;
constexpr size_t WS_CKVN = WS_CQN + SZ_CQN;
constexpr size_t SZ_CKVN = (size_t)TA * 256 * 2;
constexpr size_t WS_Q = WS_CKVN + SZ_CKVN;
constexpr size_t SZ_Q = (size_t)T * 768 * 2;
constexpr size_t WS_K = WS_Q + SZ_Q;
constexpr size_t SZ_K = (size_t)NB * NH * SKV * 96 * 2;
constexpr size_t WS_V = WS_K + SZ_K;
constexpr size_t SZ_V = (size_t)NB * NH * SKV * 64 * 2;
constexpr size_t WS_MIXIN = WS_V + SZ_V;
constexpr size_t SZ_MIXIN = (size_t)T * 1024 * 2;
constexpr size_t WS_END = WS_MIXIN + SZ_MIXIN;
constexpr size_t WS_KVRAW = WS_H1;
constexpr size_t WS_QRAW = WS_Q;
constexpr size_t WS_MIXF = WS_Q;
constexpr size_t WS_H2 = WS_PROJ;
constexpr size_t WS_QP = WS_Q;
constexpr size_t WS_EIDX = WS_PM;
constexpr size_t WS_GATES = WS_CQN;
static_assert(SZ_Q + SZ_K + SZ_V >= (size_t)T * 1024 * 4, "mixf fits");
static_assert(SZ_PM >= (size_t)T * 128 * 4 && SZ_CQN >= (size_t)T * 128 * 4, "eidx/gates fit");
static_assert(WS_END <= 512 * MB, "workspace");

__device__ __forceinline__ float bf2f(bf16_t v) { return __uint_as_float(((unsigned)v) << 16); }
__device__ __forceinline__ bf16_t f2bf(float f) { unsigned u = __float_as_uint(f); return (bf16_t)((u + 0x7fffu + ((u >> 16) & 1u)) >> 16); }
__device__ __forceinline__ float toF(float v) { return v; }
__device__ __forceinline__ float toF(bf16_t v) { return bf2f(v); }
__device__ __forceinline__ void fromF(float& d, float v) { d = v; }
__device__ __forceinline__ void fromF(bf16_t& d, float v) { d = f2bf(v); }
__device__ __forceinline__ float wave_sum(float v) {
#pragma unroll
    for (int o = 32; o > 0; o >>= 1) v += __shfl_xor(v, o);
    return v;
}

__global__ void __launch_bounds__(256) k_mod(const float* __restrict__ c, const float* __restrict__ c_ctx, const float* __restrict__ w_ada,
                                             const float* __restrict__ b_ada, float* __restrict__ mod, float* __restrict__ rope) {
    const int j = blockIdx.x * 256 + threadIdx.x, b = blockIdx.y;
    if (b == 17) {
        if (j < 512) { const int pos = j >> 3, i = j & 7; const float inv = 1.0f / powf(10000.0f, (float)i / 8.0f); const float a = (float)pos * inv; rope[2 * j] = cosf(a); rope[2 * j + 1] = sinf(a); }
        return;
    }
    if (b == 16 && j >= 2048) return;
    const float* cv = (b < 16) ? c + b * 1024 : c_ctx;
    float acc = 0.f;
    for (int k = 0; k < 1024; ++k) { const float x = cv[k]; const float s = x / (1.0f + expf(-x)); acc += s * w_ada[(size_t)k * 6144 + j]; }
    mod[b * 6144 + j] = acc + b_ada[j];
}

__global__ void __launch_bounds__(256) k_h1(const float* __restrict__ x, const float* __restrict__ ctx, const float* __restrict__ g, const float* __restrict__ mod, bf16_t* __restrict__ h1) {
    __shared__ float red[4];
    const int r = blockIdx.x, tid = threadIdx.x;
    const float* src; const float* md;
    if (r < T) { src = x + (size_t)r * D; md = mod + (r / S) * 6144; } else { src = ctx + (size_t)(r - T) * D; md = mod + 16 * 6144; }
    const float4 v = *(const float4*)(src + tid * 4);
    float ss = v.x * v.x + v.y * v.y + v.z * v.z + v.w * v.w;
    ss = wave_sum(ss);
    if ((tid & 63) == 0) red[tid >> 6] = ss;
    __syncthreads();
    const float tot = red[0] + red[1] + red[2] + red[3];
    const float rstd = rsqrtf(tot / (float)D + EPS);
    const float vv[4] = {v.x, v.y, v.z, v.w};
#pragma unroll
    for (int i = 0; i < 4; ++i) { const int col = tid * 4 + i; const float y = vv[i] * rstd * g[col]; h1[(size_t)r * D + col] = f2bf(y * (1.0f + md[D + col]) + md[col]); }
}

template <typename TA_, typename TB_, typename TC_>
__global__ void __launch_bounds__(256) k_gemm(const TA_* __restrict__ A, int lda, const TB_* __restrict__ Bm, int ldb, TC_* __restrict__ C, int ldc, int M, int N, int K) {
    __shared__ float As[16][68];
    __shared__ float Bs[16][68];
    const int tid = threadIdx.x, tx = tid & 15, ty = tid >> 4;
    const int m0 = blockIdx.y * 64, n0 = blockIdx.x * 64;
    float acc[4][4];
#pragma unroll
    for (int i = 0; i < 4; ++i)
#pragma unroll
        for (int j = 0; j < 4; ++j) acc[i][j] = 0.f;
    for (int k0 = 0; k0 < K; k0 += 16) {
#pragma unroll
        for (int i = 0; i < 4; ++i) { const int e = tid + 256 * i; const int r = e >> 4, kk = e & 15; As[kk][r] = toF(A[(size_t)(m0 + r) * lda + k0 + kk]); }
#pragma unroll
        for (int i = 0; i < 4; ++i) { const int e = tid + 256 * i; const int kk = e >> 6, cc = e & 63; Bs[kk][cc] = (n0 + cc < N) ? toF(Bm[(size_t)(k0 + kk) * ldb + n0 + cc]) : 0.f; }
        __syncthreads();
#pragma unroll
        for (int kk = 0; kk < 16; ++kk) {
            float a[4], b[4];
#pragma unroll
            for (int i = 0; i < 4; ++i) { a[i] = As[kk][ty * 4 + i]; b[i] = Bs[kk][tx * 4 + i]; }
#pragma unroll
            for (int i = 0; i < 4; ++i)
#pragma unroll
                for (int j = 0; j < 4; ++j) acc[i][j] += a[i] * b[j];
        }
        __syncthreads();
    }
#pragma unroll
    for (int i = 0; i < 4; ++i)
#pragma unroll
        for (int j = 0; j < 4; ++j) { const int n = n0 + tx * 4 + j; if (n < N) fromF(C[(size_t)(m0 + ty * 4 + i) * ldc + n], acc[i][j]); }
}

__global__ void __launch_bounds__(256) k_pm(const bf16_t* __restrict__ proj, bf16_t* __restrict__ pm) {
    const int idx = blockIdx.x * 256 + threadIdx.x;
    const int t = idx >> 9, cidx = idx & 511, g = cidx >> 7, w = 2 << g;
    const int s = t & (S - 1), b = t >> 11;
    int lo = s - w / 2; if (lo < 0) lo = 0;
    int hi = s + w / 2; if (hi > S) hi = S;
    float sum = 0.f;
    for (int j = lo; j < hi; ++j) sum += bf2f(proj[(size_t)(b * S + j) * PLD + cidx]);
    const float mean = sum / (float)(hi - lo);
    pm[(size_t)t * 512 + cidx] = f2bf(mean - bf2f(proj[(size_t)t * PLD + cidx]));
}
__global__ void __launch_bounds__(256) k_pool(const bf16_t* __restrict__ pm, const float* __restrict__ pool_w, const float* __restrict__ pool_scale, bf16_t* __restrict__ mixin) {
    const int idx = blockIdx.x * 256 + threadIdx.x;
    const int t = idx >> 9, j = idx & 511, g = j >> 7, jj = j & 127;
    float acc = 0.f;
    for (int cc = 0; cc < 128; ++cc) acc += bf2f(pm[(size_t)t * 512 + g * 128 + cc]) * pool_w[(g * 128 + cc) * 128 + jj];
    mixin[(size_t)t * 1024 + j] = f2bf(acc * pool_scale[j]);
}

__global__ void __launch_bounds__(256) k_rms(const bf16_t* __restrict__ in, int ld_in, int col0, int n, const float* __restrict__ g, bf16_t* __restrict__ out, int ld_out, int rows) {
    const int r = blockIdx.x * 4 + (threadIdx.x >> 6), lane = threadIdx.x & 63;
    if (r >= rows) return;
    float ss = 0.f;
    for (int cc = lane; cc < n; cc += 64) { const float v = bf2f(in[(size_t)r * ld_in + col0 + cc]); ss += v * v; }
    ss = wave_sum(ss);
    const float rstd = rsqrtf(ss / (float)n + EPS);
    for (int cc = lane; cc < n; cc += 64) { const float v = bf2f(in[(size_t)r * ld_in + col0 + cc]); out[(size_t)r * ld_out + cc] = f2bf(v * rstd * g[cc]); }
}

__device__ __forceinline__ void rope32(float* r, const float* __restrict__ rope, int s) {
    const int row = s >> 6, col = s & 63;
#pragma unroll
    for (int a = 0; a < 2; ++a) {
        const int pos = a ? col : row;
#pragma unroll
        for (int i = 0; i < 8; ++i) {
            const float cs = rope[(pos * 8 + i) * 2], sn = rope[(pos * 8 + i) * 2 + 1];
            const float x0 = r[a * 16 + i], x1 = r[a * 16 + 8 + i];
            r[a * 16 + i] = x0 * cs - x1 * sn;
            r[a * 16 + 8 + i] = x1 * cs + x0 * sn;
        }
    }
}
__global__ void __launch_bounds__(256) k_qfin(const bf16_t* __restrict__ qraw, const float* __restrict__ g_qk_q, const float* __restrict__ rope, bf16_t* __restrict__ Q) {
    const int idx = blockIdx.x * 256 + threadIdx.x;
    const int t = idx >> 3, h = idx & 7, b = t >> 11, s = t & (S - 1);
    const bf16_t* src = qraw + (size_t)t * 768 + h * 96;
    float ss = 0.f;
    for (int i = 0; i < 96; ++i) { const float v = bf2f(src[i]); ss += v * v; }
    const float rstd = rsqrtf(ss / 96.0f + EPS);
    const float sc = 0.10206207261596577f;
    float r[32];
#pragma unroll
    for (int i = 0; i < 32; ++i) r[i] = bf2f(src[64 + i]) * rstd * g_qk_q[64 + i];
    rope32(r, rope, s);
    bf16_t* dst = Q + ((size_t)(b * NH + h) * S + s) * 96;
    for (int i = 0; i < 64; ++i) dst[i] = f2bf(bf2f(src[i]) * rstd * g_qk_q[i] * sc);
#pragma unroll
    for (int i = 0; i < 32; ++i) dst[64 + i] = f2bf(r[i] * sc);
}
__global__ void __launch_bounds__(256) k_kvfin(const bf16_t* __restrict__ kvraw, const bf16_t* __restrict__ proj, const float* __restrict__ g_qk_k, const float* __restrict__ rope,
                                               bf16_t* __restrict__ Kb, bf16_t* __restrict__ Vb) {
    const int idx = blockIdx.x * 256 + threadIdx.x;
    const int r = idx >> 3, h = idx & 7;
    if (r >= TA) return;
    int b, key; bool lat = r < T;
    if (lat) { b = r >> 11; key = r & (S - 1); } else { b = (r - T) >> 8; key = S + ((r - T) & 255); }
    const bf16_t* kn = kvraw + (size_t)r * 1024 + h * 128;
    const bf16_t* kr = proj + (size_t)r * PLD + O_KR;
    float ss = 0.f;
    for (int i = 0; i < 64; ++i) { const float v = bf2f(kn[i]); ss += v * v; }
    float rr[32];
#pragma unroll
    for (int i = 0; i < 32; ++i) { rr[i] = bf2f(kr[i]); ss += rr[i] * rr[i]; }
    const float rstd = rsqrtf(ss / 96.0f + EPS);
#pragma unroll
    for (int i = 0; i < 32; ++i) rr[i] = rr[i] * rstd * g_qk_k[64 + i];
    if (lat) rope32(rr, rope, key);
    bf16_t* kd = Kb + ((size_t)(b * NH + h) * SKV + key) * 96;
    for (int i = 0; i < 64; ++i) kd[i] = f2bf(bf2f(kn[i]) * rstd * g_qk_k[i]);
#pragma unroll
    for (int i = 0; i < 32; ++i) kd[64 + i] = f2bf(rr[i]);
    bf16_t* vd = Vb + ((size_t)(b * NH + h) * SKV + key) * 64;
    for (int i = 0; i < 64; ++i) vd[i] = kn[64 + i];
}

__global__ void __launch_bounds__(128) k_attn(const bf16_t* __restrict__ Q, const bf16_t* __restrict__ Kb, const bf16_t* __restrict__ Vb, bf16_t* __restrict__ mixin) {
    __shared__ float Ks[32][96];
    __shared__ float Vs[32][64];
    const int tid = threadIdx.x;
    const int bh = blockIdx.x >> 4, qb = blockIdx.x & 15;
    const int s = qb * 128 + tid;
    const bf16_t* qp = Q + ((size_t)bh * S + s) * 96;
    float q[96], o[64];
#pragma unroll
    for (int i = 0; i < 96; ++i) q[i] = bf2f(qp[i]);
#pragma unroll
    for (int i = 0; i < 64; ++i) o[i] = 0.f;
    float m = -1e30f, l = 0.f;
    const bf16_t* kbase = Kb + (size_t)bh * SKV * 96;
    const bf16_t* vbase = Vb + (size_t)bh * SKV * 64;
    for (int k0 = 0; k0 < SKV; k0 += 32) {
        __syncthreads();
        for (int e = tid; e < 32 * 96; e += 128) (&Ks[0][0])[e] = bf2f(kbase[(size_t)k0 * 96 + e]);
        for (int e = tid; e < 32 * 64; e += 128) (&Vs[0][0])[e] = bf2f(vbase[(size_t)k0 * 64 + e]);
        __syncthreads();
        float sc[32];
        float tmax = -1e30f;
#pragma unroll
        for (int j = 0; j < 32; ++j) {
            float a = 0.f;
#pragma unroll
            for (int d = 0; d < 96; ++d) a += q[d] * Ks[j][d];
            sc[j] = a; tmax = fmaxf(tmax, a);
        }
        const float mn = fmaxf(m, tmax);
        const float alpha = expf(m - mn);
        l *= alpha;
#pragma unroll
        for (int i = 0; i < 64; ++i) o[i] *= alpha;
#pragma unroll
        for (int j = 0; j < 32; ++j) {
            const float p = expf(sc[j] - mn);
            l += p;
#pragma unroll
            for (int i = 0; i < 64; ++i) o[i] += p * Vs[j][i];
        }
        m = mn;
    }
    const float inv = 1.0f / l;
    const int b = bh >> 3, h = bh & 7;
    bf16_t* dst = mixin + (size_t)(b * S + s) * 1024 + 512 + h * 64;
#pragma unroll
    for (int i = 0; i < 64; ++i) dst[i] = f2bf(o[i] * inv);
}

__global__ void __launch_bounds__(256) k_resid(const float* __restrict__ x, const float* __restrict__ mixf, const float* __restrict__ mod, const float* __restrict__ g2, float* __restrict__ out, bf16_t* __restrict__ h2) {
    __shared__ float red[4];
    const int r = blockIdx.x, tid = threadIdx.x;
    const float* md = mod + (r / S) * 6144;
    const float4 xv = *(const float4*)(x + (size_t)r * D + tid * 4);
    const float4 mv = *(const float4*)(mixf + (size_t)r * D + tid * 4);
    const float4 gv = *(const float4*)(md + 2 * D + tid * 4);
    float v[4] = {xv.x + gv.x * mv.x, xv.y + gv.y * mv.y, xv.z + gv.z * mv.z, xv.w + gv.w * mv.w};
    *(float4*)(out + (size_t)r * D + tid * 4) = make_float4(v[0], v[1], v[2], v[3]);
    float ss = v[0] * v[0] + v[1] * v[1] + v[2] * v[2] + v[3] * v[3];
    ss = wave_sum(ss);
    if ((tid & 63) == 0) red[tid >> 6] = ss;
    __syncthreads();
    const float rstd = rsqrtf((red[0] + red[1] + red[2] + red[3]) / (float)D + EPS);
#pragma unroll
    for (int i = 0; i < 4; ++i) { const int col = tid * 4 + i; const float y = v[i] * rstd * g2[col]; h2[(size_t)r * D + col] = f2bf(y * (1.0f + md[4 * D + col]) + md[3 * D + col]); }
}

__device__ __forceinline__ void wave_argmax(float& v, int& i) {
#pragma unroll
    for (int o = 32; o > 0; o >>= 1) {
        const float ov = __shfl_xor(v, o); const int oi = __shfl_xor(i, o);
        if (ov > v || (ov == v && oi < i)) { v = ov; i = oi; }
    }
}
__global__ void __launch_bounds__(256) k_topk(const bf16_t* __restrict__ qp, const float* __restrict__ sub_keys, int* __restrict__ eidx, float* __restrict__ gates) {
    const int wv = blockIdx.x * 4 + (threadIdx.x >> 6), lane = threadIdx.x & 63;
    const int t = wv >> 3, h = wv & 7;
    float selv[2]; int seli[2];
#pragma unroll
    for (int p = 0; p < 2; ++p) {
        const bf16_t* qv = qp + (size_t)t * 2048 + h * 256 + p * 128;
        const float* k0 = sub_keys + ((size_t)p * 128 + lane) * 128;
        const float* k1 = k0 + 64 * 128;
        float a0 = 0.f, a1 = 0.f;
        for (int d = 0; d < 128; ++d) { const float qd = bf2f(qv[d]); a0 += qd * k0[d]; a1 += qd * k1[d]; }
        float sv = 0.f; int si = 0;
        for (int k = 0; k < 16; ++k) {
            float bv; int bi;
            if (a0 >= a1) { bv = a0; bi = lane; } else { bv = a1; bi = lane + 64; }
            wave_argmax(bv, bi);
            if (lane == k) { sv = bv; si = bi; }
            if (bi == lane) a0 = -INFINITY;
            if (bi == lane + 64) a1 = -INFINITY;
        }
        selv[p] = sv; seli[p] = si;
    }
    float cv[4]; int ci[4];
#pragma unroll
    for (int j = 0; j < 4; ++j) {
        const int pos = lane + 64 * j, a = pos >> 4, bb = pos & 15;
        cv[j] = __shfl(selv[0], a) + __shfl(selv[1], bb);
        ci[j] = __shfl(seli[0], a) * 128 + __shfl(seli[1], bb);
    }
    float tv = 0.f; int te = 0;
    for (int k = 0; k < 16; ++k) {
        float bv = cv[0]; int bp = lane;
#pragma unroll
        for (int j = 1; j < 4; ++j) if (cv[j] > bv) { bv = cv[j]; bp = lane + 64 * j; }
        wave_argmax(bv, bp);
        const int ownl = bp & 63, ownj = bp >> 6;
        int e = 0;
#pragma unroll
        for (int j = 0; j < 4; ++j) if (ownj == j) e = ci[j];
        e = __shfl(e, ownl);
        if (lane == k) { tv = bv; te = e; }
        if (lane == ownl) {
#pragma unroll
            for (int j = 0; j < 4; ++j) if (ownj == j) cv[j] = -INFINITY;
        }
    }
    const float mx = __shfl(tv, 0);
    float ex = (lane < 16) ? expf(tv - mx) : 0.f;
    const float sum = wave_sum(ex);
    if (lane < 16) { eidx[(size_t)t * 128 + h * 16 + lane] = te; gates[(size_t)t * 128 + h * 16 + lane] = ex / sum; }
}

__global__ void __launch_bounds__(256) k_peer(const bf16_t* __restrict__ h2, const int* __restrict__ eidx, const float* __restrict__ gates, const float* __restrict__ pu, const float* __restrict__ pv,
                                              const float* __restrict__ mod, float* __restrict__ out) {
    const int t = blockIdx.x * 4 + (threadIdx.x >> 6), lane = threadIdx.x & 63;
    float hx[16], y[16];
#pragma unroll
    for (int i = 0; i < 4; ++i)
#pragma unroll
        for (int j = 0; j < 4; ++j) { hx[i * 4 + j] = bf2f(h2[(size_t)t * D + i * 256 + lane * 4 + j]); y[i * 4 + j] = 0.f; }
    for (int e = 0; e < 128; ++e) {
        const int id = eidx[(size_t)t * 128 + e]; const float gt = gates[(size_t)t * 128 + e];
        const float* ur = pu + (size_t)id * D; const float* vr = pv + (size_t)id * D;
        float dot = 0.f;
#pragma unroll
        for (int i = 0; i < 4; ++i) { const float4 u4 = *(const float4*)(ur + i * 256 + lane * 4); dot += hx[i * 4] * u4.x + hx[i * 4 + 1] * u4.y + hx[i * 4 + 2] * u4.z + hx[i * 4 + 3] * u4.w; }
        dot = wave_sum(dot);
        const float act = 0.5f * dot * (1.0f + erff(dot * 0.70710678118654752f));
        const float cf = gt * act;
#pragma unroll
        for (int i = 0; i < 4; ++i) { const float4 v4 = *(const float4*)(vr + i * 256 + lane * 4); y[i * 4] += cf * v4.x; y[i * 4 + 1] += cf * v4.y; y[i * 4 + 2] += cf * v4.z; y[i * 4 + 3] += cf * v4.w; }
    }
    const float* g2 = mod + (t / S) * 6144 + 5 * D;
#pragma unroll
    for (int i = 0; i < 4; ++i) {
        float4* op = (float4*)(out + (size_t)t * D + i * 256 + lane * 4);
        float4 ov = *op; const float4 gv = *(const float4*)(g2 + i * 256 + lane * 4);
        ov.x += gv.x * y[i * 4]; ov.y += gv.y * y[i * 4 + 1]; ov.z += gv.z * y[i * 4 + 2]; ov.w += gv.w * y[i * 4 + 3];
        *op = ov;
    }
}

extern "C" void kernel_launch(void* const* d_in, const int* in_sizes, int n_in, void* d_out, int out_size, void* d_ws, size_t ws_size, hipStream_t stream) {
    const float* x = (const float*)d_in[0];
    const float* c = (const float*)d_in[1];
    const float* ctx = (const float*)d_in[2];
    const float* c_ctx = (const float*)d_in[3];
    const float* w_ada = (const float*)d_in[4];
    const float* b_ada = (const float*)d_in[5];
    const float* g_norm1 = (const float*)d_in[6];
    const float* w_in = (const float*)d_in[7];
    const float* pool_w = (const float*)d_in[8];
    const float* pool_scale = (const float*)d_in[9];
    const float* g_q_lora = (const float*)d_in[10];
    const float* w_q_up = (const float*)d_in[11];
    const float* g_kv_lora = (const float*)d_in[12];
    const float* w_kv_up = (const float*)d_in[13];
    const float* g_qk_q = (const float*)d_in[14];
    const float* g_qk_k = (const float*)d_in[15];
    const float* w_out = (const float*)d_in[16];
    const float* g_norm2 = (const float*)d_in[17];
    const float* peer_w_q = (const float*)d_in[18];
    const float* sub_keys = (const float*)d_in[19];
    const float* peer_u = (const float*)d_in[20];
    const float* peer_v = (const float*)d_in[21];
    float* out = (float*)d_out;
    char* ws = (char*)d_ws;
    float* mod = (float*)(ws + WS_MOD);
    float* rope = (float*)(ws + WS_ROPE);
    bf16_t* h1 = (bf16_t*)(ws + WS_H1);
    bf16_t* proj = (bf16_t*)(ws + WS_PROJ);
    bf16_t* pm = (bf16_t*)(ws + WS_PM);
    bf16_t* cqn = (bf16_t*)(ws + WS_CQN);
    bf16_t* ckvn = (bf16_t*)(ws + WS_CKVN);
    bf16_t* kvraw = (bf16_t*)(ws + WS_KVRAW);
    bf16_t* Qb = (bf16_t*)(ws + WS_Q);
    bf16_t* Kb = (bf16_t*)(ws + WS_K);
    bf16_t* Vb = (bf16_t*)(ws + WS_V);
    bf16_t* mixin = (bf16_t*)(ws + WS_MIXIN);
    float* mixf = (float*)(ws + WS_MIXF);
    bf16_t* h2 = (bf16_t*)(ws + WS_H2);
    bf16_t* qp = (bf16_t*)(ws + WS_QP);
    int* eidx = (int*)(ws + WS_EIDX);
    float* gates = (float*)(ws + WS_GATES);
    bf16_t* qraw = (bf16_t*)(ws + WS_K);

    k_mod<<<dim3(24, 18), 256, 0, stream>>>(c, c_ctx, w_ada, b_ada, mod, rope);
    k_h1<<<TA, 256, 0, stream>>>(x, ctx, g_norm1, mod, h1);
    k_gemm<bf16_t, float, bf16_t><<<dim3((INW + 63) / 64, TA / 64), 256, 0, stream>>>(h1, D, w_in, INW, proj, PLD, TA, INW, D);
    k_pm<<<T * 512 / 256, 256, 0, stream>>>(proj, pm);
    k_pool<<<T * 512 / 256, 256, 0, stream>>>(pm, pool_w, pool_scale, mixin);
    k_rms<<<T / 4, 256, 0, stream>>>(proj, PLD, O_CQ, QL, g_q_lora, cqn, QL, T);
    k_rms<<<TA / 4, 256, 0, stream>>>(proj, PLD, O_CKV, KVL, g_kv_lora, ckvn, KVL, TA);
    k_gemm<bf16_t, float, bf16_t><<<dim3(768 / 64, T / 64), 256, 0, stream>>>(cqn, QL, w_q_up, 768, qraw, 768, T, 768, QL);
    k_qfin<<<T * 8 / 256, 256, 0, stream>>>(qraw, g_qk_q, rope, Qb);
    k_gemm<bf16_t, float, bf16_t><<<dim3(1024 / 64, TA / 64), 256, 0, stream>>>(ckvn, KVL, w_kv_up, 1024, kvraw, 1024, TA, 1024, KVL);
    k_kvfin<<<TA * 8 / 256, 256, 0, stream>>>(kvraw, proj, g_qk_k, rope, Kb, Vb);
    k_attn<<<NB * NH * 16, 128, 0, stream>>>(Qb, Kb, Vb, mixin);
    k_gemm<bf16_t, float, float><<<dim3(1024 / 64, T / 64), 256, 0, stream>>>(mixin, D, w_out, D, mixf, D, T, D, D);
    k_resid<<<T, 256, 0, stream>>>(x, mixf, mod, g_norm2, out, h2);
    k_gemm<bf16_t, float, bf16_t><<<dim3(2048 / 64, T / 64), 256, 0, stream>>>(h2, D, peer_w_q, 2048, qp, 2048, T, 2048, D);
    k_topk<<<T * 8 / 4, 256, 0, stream>>>(qp, sub_keys, eidx, gates);
    k_peer<<<T / 4, 256, 0, stream>>>(h2, eidx, gates, peer_u, peer_v, mod, out);
}
```

```cpp
#include <hip/hip_runtime.h>
#include <hip/hip_cooperative_groups.h>
#include <stdint.h>
#include <stdio.h>
#include <math.h>
namespace cg = cooperative_groups;

typedef unsigned short bf16_t;

constexpr int D = 1024, NB = 16, S = 2048, T = NB * S, CTXL = 256, TC = NB * CTXL, TA = T + TC;
constexpr int INW = 1184, PW = 512, QL = 384, KVL = 256, ROPE = 32, NOPE = 64, QKH = 96, VH = 64, NH = 8;
constexpr int SKV = S + CTXL;
constexpr int PLD = 1280;
constexpr int O_CQ = 512, O_CKV = 896, O_KR = 1152;
constexpr float EPS = 1e-6f;
constexpr int NTHR = 512;

constexpr size_t MB = 1024 * 1024;
constexpr size_t WS_MOD = 0;
constexpr size_t WS_ROPE = 512 * 1024;
constexpr size_t WS_BAR = 768 * 1024;
constexpr size_t WS_H1 = 1 * MB;
constexpr size_t SZ_H1 = (size_t)TA * 1024 * 2;
constexpr size_t WS_PROJ = WS_H1 + SZ_H1;
constexpr size_t SZ_PROJ = (size_t)TA * PLD * 2;
constexpr size_t WS_PM = WS_PROJ + SZ_PROJ;
constexpr size_t SZ_PM = (size_t)T * 512 * 2;
constexpr size_t WS_CQN = WS_PM + SZ_PM;
constexpr size_t SZ_CQN = (size_t)T * 384 * 2;
constexpr size_t WS_CKVN = WS_CQN + SZ_CQN;
constexpr size_t SZ_CKVN = (size_t)TA * 256 * 2;
constexpr size_t WS_Q = WS_CKVN + SZ_CKVN;
constexpr size_t SZ_Q = (size_t)T * 768 * 2;
constexpr size_t WS_K = WS_Q + SZ_Q;
constexpr size_t SZ_K = (size_t)NB * NH * SKV * 96 * 2;
constexpr size_t WS_V = WS_K + SZ_K;
constexpr size_t SZ_V = (size_t)NB * NH * SKV * 64 * 2;
constexpr size_t WS_MIXIN = WS_V + SZ_V;
constexpr size_t SZ_MIXIN = (size_t)T * 1024 * 2;
constexpr size_t WS_END = WS_MIXIN + SZ_MIXIN;
constexpr size_t WS_KVRAW = WS_H1;
constexpr size_t WS_MIXF = WS_Q;
constexpr size_t WS_H2 = WS_PROJ;
constexpr size_t WS_QP = WS_Q;
constexpr size_t WS_EIDX = WS_PM;
constexpr size_t WS_GATES = WS_CQN;
static_assert(SZ_Q + SZ_K + SZ_V >= (size_t)T * 1024 * 4, "mixf fits");
static_assert(SZ_PM >= (size_t)T * 128 * 8 && SZ_CQN >= (size_t)T * 128 * 4, "eidx+cbuf / gates fit");
static_assert(SZ_H1 >= (size_t)T * 1024 * 2, "mixb fits");
static_assert(WS_END <= 512 * MB, "workspace");

constexpr size_t WS_WT_IN = WS_END;
constexpr size_t WS_WT_Q = WS_WT_IN + (size_t)1280 * 1024 * 2;
constexpr size_t WS_WT_KV = WS_WT_Q + (size_t)768 * 384 * 2;
constexpr size_t WS_WT_OUT = WS_WT_KV + (size_t)1024 * 256 * 2;
constexpr size_t WS_WT_PQ = WS_WT_OUT + (size_t)1024 * 1024 * 2;
constexpr size_t WS_U8 = WS_WT_PQ + (size_t)2048 * 1024 * 2;
constexpr size_t WS_V8 = WS_U8 + (size_t)16384 * 1024;
constexpr size_t WS_SU = WS_V8 + (size_t)16384 * 1024;
constexpr size_t WS_SV = WS_SU + (size_t)16384 * 4;
constexpr size_t WS_END2 = WS_SV + (size_t)16384 * 4;
static_assert(WS_END2 <= 512 * MB, "workspace");

constexpr int LDS_BYTES = 144 * 1024;

__device__ __forceinline__ float bf2f(bf16_t v) { return __uint_as_float(((unsigned)v) << 16); }
__device__ __forceinline__ bf16_t f2bf(float f) { unsigned u = __float_as_uint(f); return (bf16_t)((u + 0x7fffu + ((u >> 16) & 1u)) >> 16); }
__device__ __forceinline__ float toF(float v) { return v; }
__device__ __forceinline__ float toF(bf16_t v) { return bf2f(v); }
__device__ __forceinline__ void fromF(float& d, float v) { d = v; }
__device__ __forceinline__ void fromF(bf16_t& d, float v) { d = f2bf(v); }
__device__ __forceinline__ float wave_max(float v) {
#pragma unroll
    for (int o = 32; o > 0; o >>= 1) v = fmaxf(v, __shfl_xor(v, o));
    return v;
}
__device__ __forceinline__ float wave_sum(float v) {
#pragma unroll
    for (int o = 32; o > 0; o >>= 1) v += __shfl_xor(v, o);
    return v;
}

__device__ __forceinline__ void unpack8(const uint4& v, float* f) {
    f[0] = __uint_as_float(v.x << 16); f[1] = __uint_as_float(v.x & 0xffff0000u); f[2] = __uint_as_float(v.y << 16); f[3] = __uint_as_float(v.y & 0xffff0000u);
    f[4] = __uint_as_float(v.z << 16); f[5] = __uint_as_float(v.z & 0xffff0000u); f[6] = __uint_as_float(v.w << 16); f[7] = __uint_as_float(v.w & 0xffff0000u);
}
__device__ __forceinline__ uint4 pack8(const float* f) {
    uint4 o;
    o.x = (unsigned)f2bf(f[0]) | ((unsigned)f2bf(f[1]) << 16); o.y = (unsigned)f2bf(f[2]) | ((unsigned)f2bf(f[3]) << 16);
    o.z = (unsigned)f2bf(f[4]) | ((unsigned)f2bf(f[5]) << 16); o.w = (unsigned)f2bf(f[6]) | ((unsigned)f2bf(f[7]) << 16);
    return o;
}

__device__ __forceinline__ float sum8_dpp(float d) {
    d += __int_as_float(__builtin_amdgcn_update_dpp(0, __float_as_int(d), 0xB1, 0xF, 0xF, true));
    d += __int_as_float(__builtin_amdgcn_update_dpp(0, __float_as_int(d), 0x4E, 0xF, 0xF, true));
    d += __int_as_float(__builtin_amdgcn_update_dpp(0, __float_as_int(d), 0x141, 0xF, 0xF, true));
    return d;
}

struct Params {
    const float* in[22];
    float* out;
    char* ws;
};
struct Ctx {
    int tid, lane, wib, gthr, nthr, gwave, nwave;
};

template <bool RES>
__device__ __forceinline__ void norm_mod_rows4(int lane, const float* const (&src)[4], const float* const (&md)[4], int shift_off, int scale_off, const float* __restrict__ g, bf16_t* const (&dst)[4],
                                               const bf16_t* const (&mix)[4], int gate_off, float* const (&xout)[4], unsigned* const (&hq)[4], float* const (&hsc)[4]) {
    float4 v[4][4];
#pragma unroll
    for (int u = 0; u < 4; ++u)
#pragma unroll
        for (int hlf = 0; hlf < 2; ++hlf) { v[u][hlf * 2] = *(const float4*)(src[u] + hlf * 512 + lane * 8); v[u][hlf * 2 + 1] = *(const float4*)(src[u] + hlf * 512 + lane * 8 + 4); }
    if (RES) {
        uint4 mx[4][2];
#pragma unroll
        for (int u = 0; u < 4; ++u)
#pragma unroll
            for (int hlf = 0; hlf < 2; ++hlf) mx[u][hlf] = *(const uint4*)(mix[u] + hlf * 512 + lane * 8);
#pragma unroll
        for (int u = 0; u < 4; ++u)
#pragma unroll
            for (int hlf = 0; hlf < 2; ++hlf) {
                const int col = hlf * 512 + lane * 8;
                const float4 g0 = *(const float4*)(md[u] + gate_off + col), g1 = *(const float4*)(md[u] + gate_off + col + 4);
                float m[8]; unpack8(mx[u][hlf], m);
                float4& a = v[u][hlf * 2]; float4& bq = v[u][hlf * 2 + 1];
                a.x += g0.x * m[0]; a.y += g0.y * m[1]; a.z += g0.z * m[2]; a.w += g0.w * m[3];
                bq.x += g1.x * m[4]; bq.y += g1.y * m[5]; bq.z += g1.z * m[6]; bq.w += g1.w * m[7];
                (void)xout;
            }
    }
    float4 gg[4];
#pragma unroll
    for (int hlf = 0; hlf < 2; ++hlf) { gg[hlf * 2] = *(const float4*)(g + hlf * 512 + lane * 8); gg[hlf * 2 + 1] = *(const float4*)(g + hlf * 512 + lane * 8 + 4); }
#pragma unroll
    for (int u = 0; u < 4; ++u) {
        float ss = 0.f;
#pragma unroll
        for (int i = 0; i < 4; ++i) ss += v[u][i].x * v[u][i].x + v[u][i].y * v[u][i].y + v[u][i].z * v[u][i].z + v[u][i].w * v[u][i].w;
        ss = wave_sum(ss);
        const float rstd = rsqrtf(ss / (float)D + EPS);
        float fq[16]; float amax = 0.f;
#pragma unroll
        for (int hlf = 0; hlf < 2; ++hlf) {
            const int col = hlf * 512 + lane * 8;
            const float4 s0 = *(const float4*)(md[u] + scale_off + col), s1 = *(const float4*)(md[u] + scale_off + col + 4);
            const float4 h0 = *(const float4*)(md[u] + shift_off + col), h1v = *(const float4*)(md[u] + shift_off + col + 4);
            const float4 a = v[u][hlf * 2], bq = v[u][hlf * 2 + 1], g0 = gg[hlf * 2], g1 = gg[hlf * 2 + 1];
            float f[8];
            f[0] = a.x * rstd * g0.x * (1.0f + s0.x) + h0.x; f[1] = a.y * rstd * g0.y * (1.0f + s0.y) + h0.y; f[2] = a.z * rstd * g0.z * (1.0f + s0.z) + h0.z; f[3] = a.w * rstd * g0.w * (1.0f + s0.w) + h0.w;
            f[4] = bq.x * rstd * g1.x * (1.0f + s1.x) + h1v.x; f[5] = bq.y * rstd * g1.y * (1.0f + s1.y) + h1v.y; f[6] = bq.z * rstd * g1.z * (1.0f + s1.z) + h1v.z; f[7] = bq.w * rstd * g1.w * (1.0f + s1.w) + h1v.w;
            *(uint4*)(dst[u] + col) = pack8(f);
            if (RES) {
#pragma unroll
                for (int i = 0; i < 8; ++i) { fq[hlf * 8 + i] = bf2f(f2bf(f[i])); amax = fmaxf(amax, fabsf(fq[hlf * 8 + i])); }
            }
        }
        if (RES) {
            amax = wave_max(amax);
            const float sh = amax > 0.f ? amax * (1.0f / 119.0f) : 1.0f, ish = 1.0f / sh;
#pragma unroll
            for (int hlf = 0; hlf < 2; ++hlf) {
                unsigned whi = 0u, wlo = 0u;
#pragma unroll
                for (int i = 0; i < 8; ++i) {
                    int h8 = (int)rintf(fq[hlf * 8 + i] * ish); h8 = h8 < -119 ? -119 : (h8 > 119 ? 119 : h8);
                    const int lo = ((h8 + 8) & 15) - 8, hi = (h8 - lo) >> 4;
                    whi |= ((unsigned)hi & 0xFu) << (4 * i); wlo |= ((unsigned)lo & 0xFu) << (4 * i);
                }
                hq[u][hlf * 64 + lane] = whi; hq[u][128 + hlf * 64 + lane] = wlo;
            }
            if (lane == 0) hsc[u][0] = sh;
        }
    }
}
__device__ __forceinline__ void ph_h1(const Ctx& cx, const float* __restrict__ x, const float* __restrict__ ctx, const float* __restrict__ g, const float* __restrict__ mod, bf16_t* __restrict__ h1) {
    for (int rb = cx.gwave * 4; rb < TA; rb += cx.nwave * 4) {
        const float* src[4]; const float* md[4]; bf16_t* dst[4];
#pragma unroll
        for (int u = 0; u < 4; ++u) {
            const int r = rb + u;
            if (r < T) { src[u] = x + (size_t)r * D; md[u] = mod + (r / S) * 6144; } else { src[u] = ctx + (size_t)(r - T) * D; md[u] = mod + 16 * 6144; }
            dst[u] = h1 + (size_t)r * D;
        }
        const bf16_t* nomix[4] = {nullptr, nullptr, nullptr, nullptr}; float* noout[4] = {nullptr, nullptr, nullptr, nullptr};
        unsigned* nohq[4] = {nullptr, nullptr, nullptr, nullptr}; float* nohs[4] = {nullptr, nullptr, nullptr, nullptr};
        norm_mod_rows4<false>(cx.lane, src, md, 0, D, g, dst, nomix, 0, noout, nohq, nohs);
    }
}


namespace pg8 {
#define PG8_LAS __attribute__((address_space(3)))
typedef short bf16x8 __attribute__((ext_vector_type(8)));
typedef float f32x4 __attribute__((ext_vector_type(4)));
typedef unsigned u32x4 __attribute__((ext_vector_type(4)));
constexpr int BM = 256, BK = 64, HALF = 128, HTB = HALF * BK * 2, STAGE_BYTES = 8 * HTB, NXCD = 8, WGM = 8;
__host__ __device__ __forceinline__ int lds_byte(int r, int c) { const int st = (r >> 4) * 2 + (c >> 5), rr = r & 15, cc = c & 31, ob = rr * 64 + cc * 2; return st * 1024 + (ob ^ (((ob >> 9) & 1) << 5)); }
__host__ __device__ __forceinline__ void stage_rc(int b, int& R, int& C) { const int st = b / 1024, sb = b % 1024, swz = sb ^ (((sb >> 9) & 1) << 5); R = (st >> 1) * 16 + swz / 64; C = (st & 1) * 32 + (swz % 64) / 2; }
__host__ __device__ __forceinline__ int perm32(int rho) { const int n = rho >> 4, i = rho & 15; return 8 * (i >> 2) + 4 * n + (i & 3); }
struct Unit { int pm, pn; };
struct Gemm { const bf16_t* A; const bf16_t* Bt; int M, N, K; };
struct StaticOrder {
    int nM, nN, nwg, G, c;
    __host__ __device__ void init(int M, int N, int G_, int c_) { nM = M / BM; nN = N / BM; nwg = nM * nN; G = G_; c = c_; }
    __host__ __device__ bool next(int i, Unit& u) const {
        const long L = (long)i * G + c; if (L >= nwg) return false;
        int wgid = (int)L; { const int q = nwg / NXCD, r = nwg % NXCD, xcd = wgid % NXCD, off = wgid / NXCD; wgid = (xcd < r ? xcd * (q + 1) : r * (q + 1) + (xcd - r) * q) + off; }
        const int nig = WGM * nN, gid = wgid / nig, fm = gid * WGM, gsz = (nM - fm) < WGM ? (nM - fm) : WGM;
        u.pm = fm + ((wgid % nig) % gsz); u.pn = (wgid % nig) / gsz; return true;
    }
    __device__ __forceinline__ void a_ready(const Unit&) const {}
    __device__ __forceinline__ void done(const Unit&) const {}
};
__device__ __forceinline__ unsigned cvt_pk_bf16(float lo, float hi) { unsigned r; asm volatile("v_cvt_pk_bf16_f32 %0, %1, %2" : "=v"(r) : "v"(lo), "v"(hi)); return r; }
struct EpiBf16 {
    static constexpr bool PERM = true, AFTER_DRAIN = false;
    bf16_t* O; int ldc;
    __device__ __forceinline__ void operator()(const f32x4 (&acc)[2][2][4][2], const Unit& u, int wr, int wc, int fr, int fq) const {
        const int row0 = u.pm * BM + wr * 64 + fr, col0 = u.pn * BM + wc * 32 + 8 * fq;
#pragma unroll
        for (int ai = 0; ai < 2; ++ai)
#pragma unroll
            for (int m = 0; m < 4; ++m) { bf16_t* rowp = O + (size_t)(row0 + ai * HALF + m * 16) * ldc + col0;
#pragma unroll
                for (int bj = 0; bj < 2; ++bj) { const f32x4 v0 = acc[ai][bj][m][0], v1 = acc[ai][bj][m][1];
                    u32x4 w; w.x = cvt_pk_bf16(v0[0], v0[1]); w.y = cvt_pk_bf16(v0[2], v0[3]); w.z = cvt_pk_bf16(v1[0], v1[1]); w.w = cvt_pk_bf16(v1[2], v1[3]);
                    *(u32x4*)(rowp + bj * HALF) = w; } }
    }
};
struct EpiKV {
    static constexpr bool PERM = true, AFTER_DRAIN = false;
    bf16_t* Kb; bf16_t* Vb;
    __device__ __forceinline__ void operator()(const f32x4 (&acc)[2][2][4][2], const Unit& u, int wr, int wc, int fr, int fq) const {
        const bool lat = u.pm < (T / BM);
        const int b = lat ? (u.pm >> 3) : (u.pm - T / BM), key0 = (lat ? (u.pm & 7) * BM : S) + wr * 64 + fr;
        const int dc = (wc & 1) * 32 + 8 * fq, rec0 = (b * NH + 2 * u.pn) * SKV + key0;
        const bool isv = wc >= 2;
        const unsigned rs2 = isv ? 128u : 192u;
        char* dst = isv ? (char*)Vb : (char*)Kb;
        unsigned off = (unsigned)rec0 * rs2 + (unsigned)dc * 2u;
#pragma unroll
        for (int ai = 0; ai < 2; ++ai)
#pragma unroll
            for (int m = 0; m < 4; ++m) {
#pragma unroll
                for (int bj = 0; bj < 2; ++bj) { const f32x4 v0 = acc[ai][bj][m][0], v1 = acc[ai][bj][m][1];
                    u32x4 w; w.x = cvt_pk_bf16(v0[0], v0[1]); w.y = cvt_pk_bf16(v0[2], v0[3]); w.z = cvt_pk_bf16(v1[0], v1[1]); w.w = cvt_pk_bf16(v1[2], v1[3]);
                    *(u32x4*)(dst + (unsigned)(off + (bj ? (unsigned)SKV * rs2 : 0u))) = w; __builtin_amdgcn_sched_barrier(0); }
                off += (m == 3 ? (unsigned)(HALF - 48) : 16u) * rs2;
                asm volatile("" : "+v"(off));
            }
    }
};
struct EpiResid {
    static constexpr bool PERM = false, AFTER_DRAIN = false;
    const float* x; const float* mod; float* out;
    __device__ __forceinline__ void operator()(const f32x4 (&acc)[2][2][4][2], const Unit& u, int wr, int wc, int fr, int fq) const {
        const int row0 = u.pm * BM + wr * 64 + fr, col0 = u.pn * BM + wc * 32 + 4 * fq;
        const float* gate = mod + (size_t)((u.pm * BM) >> 11) * 6144 + 2048;
        f32x4 gv[2][2];
#pragma unroll
        for (int bj = 0; bj < 2; ++bj)
#pragma unroll
            for (int n = 0; n < 2; ++n) gv[bj][n] = *(const f32x4*)(gate + col0 + bj * HALF + n * 16);
#pragma unroll
        for (int ai = 0; ai < 2; ++ai)
#pragma unroll
            for (int m = 0; m < 4; ++m) { const size_t off = (size_t)(row0 + ai * HALF + m * 16) * 1024 + col0;
#pragma unroll
                for (int bj = 0; bj < 2; ++bj)
#pragma unroll
                    for (int n = 0; n < 2; ++n) { const f32x4 xv = *(const f32x4*)(x + off + bj * HALF + n * 16); *(f32x4*)(out + off + bj * HALF + n * 16) = xv + gv[bj][n] * acc[ai][bj][m][n]; } }
    }
};
template <class Epi, class Sched>
__device__ __forceinline__ void gemm_phase(PG8_LAS unsigned char* lds, const Gemm g, const Sched& S, const Epi& E) {
    const int tid = threadIdx.x, wid = __builtin_amdgcn_readfirstlane(tid >> 6), lane = tid & 63, wr = wid >> 2, wc = wid & 3, fr = lane & 15, fq = lane >> 4;
    const int K = g.K, nt = K / BK;
    unsigned voffA[2], voffB[2];
#pragma unroll
    for (int i = 0; i < 2; ++i) { int R, C; stage_rc(tid * 16 + i * 8192, R, C); const int Rb = Epi::PERM ? ((R & ~31) + perm32(R & 31)) : R;
        voffA[i] = (unsigned)(R * K + C) * 2u; voffB[i] = (unsigned)(Rb * K + C) * 2u; }
    const size_t kstep = (size_t)(BK * 2);
    const size_t hstep = (size_t)HALF * K * 2;
    const size_t tstep = 2 * hstep;
    const unsigned ldsw = (unsigned)wid * 1024u;
    const int aoff = lds_byte(wr * 64 + fr, fq * 8), boff = lds_byte(wc * 32 + fr, fq * 8);
#define PG8_SA(b, h) (((b) * 2 + (h)) * HTB)
#define PG8_SB(b, h) ((4 + (b) * 2 + (h)) * HTB)
#define PG8_STAGE(bufoff, gbase, voff) do { _Pragma("unroll") for (int _i = 0; _i < 2; ++_i) \
        __builtin_amdgcn_global_load_lds((const unsigned*)((const char*)(gbase) + (voff)[_i]), (PG8_LAS unsigned*)(lds + (bufoff) + ldsw + _i * 8192), 16, 0, 0); } while (0)
#define PG8_LDA(dst, b, h) do { _Pragma("unroll") for (int m = 0; m < 4; ++m) _Pragma("unroll") for (int k = 0; k < 2; ++k) dst[m][k] = *(const PG8_LAS bf16x8*)(lds + PG8_SA(b, h) + aoff + m * 2048 + k * 1024); } while (0)
#define PG8_LDB(dst, b, h) do { _Pragma("unroll") for (int n = 0; n < 2; ++n) _Pragma("unroll") for (int k = 0; k < 2; ++k) dst[n][k] = *(const PG8_LAS bf16x8*)(lds + PG8_SB(b, h) + boff + n * 2048 + k * 1024); } while (0)
#define PG8_MMA(ai, bj, At, Bt) do { __builtin_amdgcn_s_setprio(1); _Pragma("unroll") for (int m = 0; m < 4; ++m) _Pragma("unroll") for (int n = 0; n < 2; ++n) _Pragma("unroll") for (int k = 0; k < 2; ++k) \
        acc[ai][bj][m][n] = __builtin_amdgcn_mfma_f32_16x16x32_bf16(Bt[n][k], At[m][k], acc[ai][bj][m][n], 0, 0, 0); __builtin_amdgcn_s_setprio(0); } while (0)
#define PG8_WAIT_V(n) asm volatile("s_waitcnt vmcnt(" #n ")" ::: "memory")
#define PG8_WAIT_L(n) asm volatile("s_waitcnt lgkmcnt(" #n ")" ::: "memory")
#define PG8_BAR __builtin_amdgcn_s_barrier()
#define PG8_SCHED __builtin_amdgcn_sched_barrier(0)
    Unit cur, nxt; int ui = 0;
    if (!S.next(0, cur)) return;
    f32x4 acc[2][2][4][2];
#pragma unroll
    for (int a = 0; a < 2; ++a)
#pragma unroll
        for (int b = 0; b < 2; ++b)
#pragma unroll
            for (int m = 0; m < 4; ++m)
#pragma unroll
                for (int n = 0; n < 2; ++n) acc[a][b][m][n] = (f32x4){0.f, 0.f, 0.f, 0.f};
    bf16x8 At[4][2], B0[2][2], B1[2][2];
    const char* cA = (const char*)g.A + (size_t)cur.pm * tstep; const char* cB = (const char*)g.Bt + (size_t)cur.pn * tstep;
    S.a_ready(cur);
    PG8_STAGE(PG8_SB(0, 0), cB, voffB); PG8_STAGE(PG8_SA(0, 0), cA, voffA); PG8_STAGE(PG8_SB(0, 1), cB + hstep, voffB); PG8_STAGE(PG8_SA(0, 1), cA + hstep, voffA);
    if (wr == 1) PG8_BAR;
    PG8_WAIT_V(4); PG8_BAR;
    PG8_STAGE(PG8_SB(1, 0), cB + kstep, voffB); PG8_STAGE(PG8_SA(1, 0), cA + kstep, voffA); PG8_STAGE(PG8_SB(1, 1), cB + hstep + kstep, voffB);
    PG8_WAIT_V(6); PG8_BAR;
    for (;;) {
        const bool has_next = S.next(ui + 1, nxt);
        const char* nA = has_next ? (const char*)g.A + (size_t)nxt.pm * tstep : cA; const char* nB = has_next ? (const char*)g.Bt + (size_t)nxt.pn * tstep : cB;
        for (int t = 0; t < nt; t += 2) {
            const bool last = (t == nt - 2);
            const char* a1 = cA + (size_t)(t + 1) * kstep;
            const char* a2 = last ? nA : cA + (size_t)(t + 2) * kstep; const char* b2 = last ? nB : cB + (size_t)(t + 2) * kstep;
            const char* a3 = a2 + kstep; const char* b3 = b2 + kstep;
            if (last && has_next) S.a_ready(nxt);
            PG8_LDB(B0, 0, 0); PG8_SCHED; PG8_LDA(At, 0, 0); PG8_STAGE(PG8_SA(1, 1), a1 + hstep, voffA);
            PG8_WAIT_L(8); PG8_BAR; PG8_WAIT_L(0); PG8_MMA(0, 0, At, B0); PG8_BAR; PG8_SCHED;
            PG8_LDB(B1, 0, 1); PG8_STAGE(PG8_SB(0, 0), b2, voffB);
            PG8_BAR; PG8_WAIT_L(0); PG8_MMA(0, 1, At, B1); PG8_BAR;
            PG8_LDA(At, 0, 1); PG8_STAGE(PG8_SA(0, 0), a2, voffA);
            PG8_BAR; PG8_WAIT_L(0); PG8_MMA(1, 0, At, B0); PG8_BAR; PG8_SCHED;
            PG8_STAGE(PG8_SB(0, 1), b2 + hstep, voffB);
            PG8_WAIT_V(6); PG8_BAR; PG8_MMA(1, 1, At, B1); PG8_BAR;
            PG8_LDB(B0, 1, 0); PG8_SCHED; PG8_LDA(At, 1, 0); PG8_STAGE(PG8_SA(0, 1), a2 + hstep, voffA);
            PG8_WAIT_L(8); PG8_BAR; PG8_WAIT_L(0); PG8_MMA(0, 0, At, B0); PG8_BAR; PG8_SCHED;
            PG8_LDB(B1, 1, 1); PG8_STAGE(PG8_SB(1, 0), b3, voffB);
            PG8_BAR; PG8_WAIT_L(0); PG8_MMA(0, 1, At, B1); PG8_BAR;
            PG8_LDA(At, 1, 1); PG8_STAGE(PG8_SA(1, 0), a3, voffA);
            PG8_BAR; PG8_WAIT_L(0); PG8_MMA(1, 0, At, B0); PG8_BAR; PG8_SCHED;
            PG8_STAGE(PG8_SB(1, 1), b3 + hstep, voffB);
            PG8_WAIT_V(6); PG8_BAR; PG8_MMA(1, 1, At, B1); PG8_BAR;
        }
        E(acc, cur, wr, wc, fr, fq); S.done(cur);
        if (!has_next) break;
#pragma unroll
        for (int a = 0; a < 2; ++a)
#pragma unroll
            for (int b = 0; b < 2; ++b)
#pragma unroll
                for (int m = 0; m < 4; ++m)
#pragma unroll
                    for (int n = 0; n < 2; ++n) acc[a][b][m][n] = (f32x4){0.f, 0.f, 0.f, 0.f};
        cur = nxt; cA = nA; cB = nB; ++ui;
    }
    PG8_WAIT_V(0);
    if (wr == 0) PG8_BAR;
    PG8_BAR;
#undef PG8_SA
#undef PG8_SB
#undef PG8_STAGE
#undef PG8_LDA
#undef PG8_LDB
#undef PG8_MMA
#undef PG8_WAIT_V
#undef PG8_WAIT_L
#undef PG8_BAR
#undef PG8_SCHED
}
}

template <class Epi>
__device__ __forceinline__ void run_gemm(char* lds, const bf16_t* A, const bf16_t* Bt, int M, int N, int K, const Epi& E, bool reverse = false) {
    pg8::Gemm g{A, Bt, M, N, K}; pg8::StaticOrder S; S.init(M, N, (int)gridDim.x, reverse ? (int)(gridDim.x - 1 - blockIdx.x) : (int)blockIdx.x);
    pg8::gemm_phase<Epi, pg8::StaticOrder>((PG8_LAS unsigned char*)lds, g, S, E);
}

struct WtTile { const float* W; bf16_t* Wt; int N, ldt, koff, k0, n0; };
__device__ __forceinline__ WtTile wt_pick(int tI, const float* w_in, const float* w_q_up, const float* w_kv_up, const float* w_out, const float* peer_w_q,
                                          bf16_t* wt_in, bf16_t* wt_q, bf16_t* wt_kv, bf16_t* wt_out, bf16_t* wt_pq) {
    WtTile t; int ntk, loc;
    if (tI < 320)      { t.W = w_in;     t.Wt = wt_in;  t.N = INW;  t.ldt = 1024; t.koff = 0;   ntk = 16; loc = tI; }
    else if (tI < 392) { t.W = w_q_up;   t.Wt = wt_q;   t.N = 768;  t.ldt = QL;   t.koff = 0;   ntk = 6;  loc = tI - 320; }
    else if (tI < 456) { t.W = w_kv_up;  t.Wt = wt_kv;  t.N = 1024; t.ldt = KVL;  t.koff = 0;   ntk = 4;  loc = tI - 392; }
    else if (tI < 584) { t.W = w_out + (size_t)512 * 1024; t.Wt = wt_out; t.N = 1024; t.ldt = 1024; t.koff = 512; ntk = 8; loc = tI - 456; }
    else               { t.W = peer_w_q; t.Wt = wt_pq;  t.N = 2048; t.ldt = 1024; t.koff = 0;   ntk = 16; loc = tI - 584; }
    t.k0 = (loc % ntk) * 64; t.n0 = (loc / ntk) * 64;
    return t;
}
constexpr int WT_TILES = 320 + 72 + 64 + 128 + 512;
__device__ __forceinline__ void ph_wt_all(const Ctx& cx, char* lds, const float* w_in, const float* w_q_up, const float* w_kv_up, const float* w_out, const float* peer_w_q,
                                          bf16_t* wt_in, bf16_t* wt_q, bf16_t* wt_kv, bf16_t* wt_out, bf16_t* wt_pq) {
    float (*tile)[64][65] = (float (*)[64][65])lds;
    const int G = (int)gridDim.x;
    for (int base = blockIdx.x; base < WT_TILES; base += 5 * G) {
        float v[5][8];
#pragma unroll
        for (int s5 = 0; s5 < 5; ++s5) {
            const int tI = base + s5 * G;
            if (tI < WT_TILES) {
                const WtTile t = wt_pick(tI, w_in, w_q_up, w_kv_up, w_out, peer_w_q, wt_in, wt_q, wt_kv, wt_out, wt_pq);
#pragma unroll
                for (int i = 0; i < 8; ++i) { const int e = cx.tid + 512 * i; const int kk = e >> 6, nn = e & 63; v[s5][i] = (t.n0 + nn < t.N) ? t.W[(size_t)(t.k0 + kk) * t.N + t.n0 + nn] : 0.f; }
            }
        }
        __syncthreads();
#pragma unroll
        for (int s5 = 0; s5 < 5; ++s5) {
            if (base + s5 * G < WT_TILES) {
#pragma unroll
                for (int i = 0; i < 8; ++i) { const int e = cx.tid + 512 * i; tile[s5][e >> 6][e & 63] = v[s5][i]; }
            }
        }
        __syncthreads();
#pragma unroll
        for (int s5 = 0; s5 < 5; ++s5) {
            const int tI = base + s5 * G;
            if (tI < WT_TILES) {
                const WtTile t = wt_pick(tI, w_in, w_q_up, w_kv_up, w_out, peer_w_q, wt_in, wt_q, wt_kv, wt_out, wt_pq);
#pragma unroll
                for (int i = 0; i < 4; ++i) {
                    const int e = cx.tid + 512 * i; const int nn = e >> 5, kp = e & 31;
                    *(unsigned*)(t.Wt + (size_t)(t.n0 + nn) * t.ldt + t.koff + t.k0 + 2 * kp) = (unsigned)f2bf(tile[s5][2 * kp][nn]) | ((unsigned)f2bf(tile[s5][2 * kp + 1][nn]) << 16);
                }
            }
        }
    }
    __syncthreads();
}

__device__ __forceinline__ void ph_h2(const Ctx& cx, const float* __restrict__ x, const bf16_t* __restrict__ mixb, const float* __restrict__ mod, const float* __restrict__ g2, float* __restrict__ out, bf16_t* __restrict__ h2,
                                      unsigned* __restrict__ hqn, float* __restrict__ hs) {
    for (int rb = cx.gwave * 4; rb < T; rb += cx.nwave * 4) {
        const float* src[4]; const float* md[4]; bf16_t* dst[4]; const bf16_t* mx[4]; float* xo[4]; unsigned* hq4[4]; float* hs4[4];
#pragma unroll
        for (int u = 0; u < 4; ++u) { const int r = rb + u; src[u] = x + (size_t)r * D; md[u] = mod + (r / S) * 6144; dst[u] = h2 + (size_t)r * D; mx[u] = mixb + (size_t)r * D; xo[u] = out + (size_t)r * D;
            hq4[u] = hqn + (size_t)r * 256; hs4[u] = hs + r; }
        norm_mod_rows4<true>(cx.lane, src, md, 3 * D, 4 * D, g2, dst, mx, 2 * D, xo, hq4, hs4);
    }
}

namespace att {
using bf16x8 = __attribute__((ext_vector_type(8))) short;
using s16x4  = __attribute__((ext_vector_type(4))) short;
using f32x16 = __attribute__((ext_vector_type(16))) float;
using u32x4  = __attribute__((ext_vector_type(4))) unsigned;
constexpr int KROW = 208;
constexpr int SHM_V = 64 * 64 * 2, SHM_K = 64 * KROW, SHM_ATTN = 2 * SHM_V + 2 * SHM_K + 8 * 64 * 4;
constexpr float SCALE = 0.10206207261596577f;
constexpr float THR = 8.f;
constexpr int LDQ = 768, LDO = 1024;
#define ATT_SBAR() __builtin_amdgcn_sched_barrier(0)
__device__ __forceinline__ int crow(int r, int hi) { return (r & 3) + 8 * (r >> 2) + 4 * hi; }
__device__ __forceinline__ unsigned cvtpk(float lo, float hi) { unsigned r; asm volatile("v_cvt_pk_bf16_f32 %0, %1, %2" : "=v"(r) : "v"(lo), "v"(hi)); return r; }
__device__ __forceinline__ void partialSM(f32x16& p0, f32x16& p1, float& m_reg, float& mn, float& alpha) {
  constexpr float C = SCALE * 1.4426950408889634f;
  float pmax = p0[0];
#pragma unroll
  for (int r = 1; r < 16; ++r) pmax = fmaxf(pmax, p0[r]);
#pragma unroll
  for (int r = 0; r < 16; ++r) pmax = fmaxf(pmax, p1[r]);
  { auto rr = __builtin_amdgcn_permlane32_swap(__float_as_uint(pmax), __float_as_uint(pmax), false, false);
    pmax = fmaxf(__uint_as_float(rr[0]), __uint_as_float(rr[1])); }
  if (__builtin_expect(__all(pmax - m_reg <= THR / SCALE), 1)) { mn = m_reg; alpha = 1.f; }
  else { mn = fmaxf(m_reg, pmax); alpha = __builtin_amdgcn_exp2f((m_reg - mn) * C); m_reg = mn; }
  float mnC = -mn * C;
#pragma unroll
  for (int r = 0; r < 16; ++r) p0[r] = fmaf(p0[r], C, mnC);
#pragma unroll
  for (int r = 0; r < 16; ++r) p1[r] = fmaf(p1[r], C, mnC);
#pragma unroll
  for (int r = 0; r < 16; ++r) p0[r] = __builtin_amdgcn_exp2f(p0[r]);
}
__device__ __forceinline__ void finishSM(f32x16& p0, f32x16& p1, float alpha, float& l_reg, bf16x8& pa0, bf16x8& pa1, bf16x8& pa2, bf16x8& pa3) {
#pragma unroll
  for (int r = 0; r < 16; ++r) p1[r] = __builtin_amdgcn_exp2f(p1[r]);
  (void)alpha; (void)l_reg;
#define ATT_PK4(P, BASE, OUT) do { unsigned a0 = cvtpk(P[BASE + 0], P[BASE + 1]), a1 = cvtpk(P[BASE + 2], P[BASE + 3]);   \
    unsigned b0 = cvtpk(P[BASE + 4], P[BASE + 5]), b1 = cvtpk(P[BASE + 6], P[BASE + 7]);                              \
    auto r0 = __builtin_amdgcn_permlane32_swap(a0, b0, false, false); auto r1 = __builtin_amdgcn_permlane32_swap(a1, b1, false, false); \
    u32x4 w = {r0[0], r1[0], r0[1], r1[1]}; OUT = *reinterpret_cast<bf16x8*>(&w); } while (0)
  ATT_PK4(p0, 0, pa0); ATT_PK4(p0, 8, pa1); ATT_PK4(p1, 0, pa2); ATT_PK4(p1, 8, pa3);
#undef ATT_PK4
}
__device__ __forceinline__ void qkt(f32x16& p0, f32x16& p1, const char* Ks, const bf16x8* qr, int r32, int hi) {
  p0 = f32x16{}; p1 = f32x16{};
#pragma unroll
  for (int d0 = 0; d0 < 6; ++d0) { const int cb = (d0 * 16 + hi * 8) * 2;
    bf16x8 b0 = *reinterpret_cast<const bf16x8*>(Ks + r32 * KROW + cb);
    bf16x8 b1 = *reinterpret_cast<const bf16x8*>(Ks + (32 + r32) * KROW + cb);
    p0 = __builtin_amdgcn_mfma_f32_32x32x16_bf16(b0, qr[d0], p0, 0, 0, 0);
    p1 = __builtin_amdgcn_mfma_f32_32x32x16_bf16(b1, qr[d0], p1, 0, 0, 0); }
}
__device__ __forceinline__ int v_st(int k, int c) { const int kk = (k & ~0xC) | ((k & 4) << 1) | ((k & 8) >> 1); return ((kk >> 3) * 2 + (c >> 5)) * 512 + ((kk & 7) * 32 + (c & 31)) * 2; }
__device__ __forceinline__ int v_rd_base(int lane) { return ((lane & 3) << 3) | (((lane >> 2) & 3) << 6) | (((lane >> 4) & 1) << 5) | (((lane >> 5) & 1) << 8); }
constexpr int v_rd_off(int d0, int ks, int half) { return d0 * 512 + ks * 2048 + half * 1024; }
template <int OFF> __device__ __forceinline__ s16x4 tr_read(int vb) {
  s16x4 r; asm volatile("ds_read_b64_tr_b16 %0, %1 offset:%2" : "=&v"(r) : "v"(vb), "i"(OFF) : "memory"); return r;
}
template <int D0> __device__ __forceinline__ void pv_one(f32x16& od, int vb, bf16x8 pa0, bf16x8 pa1, bf16x8 pa2, bf16x8 pa3) {
  const s16x4 l0 = tr_read<v_rd_off(D0, 0, 0)>(vb), h0 = tr_read<v_rd_off(D0, 0, 1)>(vb), l1 = tr_read<v_rd_off(D0, 1, 0)>(vb), h1 = tr_read<v_rd_off(D0, 1, 1)>(vb);
  const s16x4 l2 = tr_read<v_rd_off(D0, 2, 0)>(vb), h2 = tr_read<v_rd_off(D0, 2, 1)>(vb), l3 = tr_read<v_rd_off(D0, 3, 0)>(vb), h3 = tr_read<v_rd_off(D0, 3, 1)>(vb);
  asm volatile("s_waitcnt lgkmcnt(0)" ::: "memory"); ATT_SBAR();
#define ATT_PK(L, H) (bf16x8){L[0], L[1], L[2], L[3], H[0], H[1], H[2], H[3]}
  od = __builtin_amdgcn_mfma_f32_32x32x16_bf16(pa0, ATT_PK(l0, h0), od, 0, 0, 0);
  od = __builtin_amdgcn_mfma_f32_32x32x16_bf16(pa1, ATT_PK(l1, h1), od, 0, 0, 0);
  od = __builtin_amdgcn_mfma_f32_32x32x16_bf16(pa2, ATT_PK(l2, h2), od, 0, 0, 0);
  od = __builtin_amdgcn_mfma_f32_32x32x16_bf16(pa3, ATT_PK(l3, h3), od, 0, 0, 0);
#undef ATT_PK
}
__device__ __forceinline__ void pv_d0(f32x16* o, int vb, bf16x8 pa0, bf16x8 pa1, bf16x8 pa2, bf16x8 pa3) {
  pv_one<0>(o[0], vb, pa0, pa1, pa2, pa3); pv_one<1>(o[1], vb, pa0, pa1, pa2, pa3);
  const bf16x8 ones = {0x3F80, 0x3F80, 0x3F80, 0x3F80, 0x3F80, 0x3F80, 0x3F80, 0x3F80};
  o[2] = __builtin_amdgcn_mfma_f32_32x32x16_bf16(pa0, ones, o[2], 0, 0, 0);
  o[2] = __builtin_amdgcn_mfma_f32_32x32x16_bf16(pa1, ones, o[2], 0, 0, 0);
  o[2] = __builtin_amdgcn_mfma_f32_32x32x16_bf16(pa2, ones, o[2], 0, 0, 0);
  o[2] = __builtin_amdgcn_mfma_f32_32x32x16_bf16(pa3, ones, o[2], 0, 0, 0);
}
__device__ __forceinline__ void attn_body(const bf16_t* __restrict__ Qb, const bf16_t* __restrict__ Kh, const bf16_t* __restrict__ Vh, bf16_t* __restrict__ Ob, int seq, char* lds,
                                          const float* __restrict__ gq, const float* __restrict__ rope, int s0) {
  int tid = threadIdx.x; asm volatile("" : "+v"(tid));
  const int wid = tid >> 6, lane = tid & 63, r32 = lane & 31, hi = lane >> 5;
  char* V_lds = lds; char* K_lds = lds + 2 * SHM_V;
  float* wsl = (float*)(lds + 2 * SHM_V + 2 * SHM_K) + wid * 64; float* li_l = wsl; float* al_l = wsl + 32;
  float m_reg = -1e30f, l_reg = 0; f32x16 o[3] = {}; bf16x8 qr[6];
  const bf16_t* Qw = Qb + (long)(wid * 32 + r32) * LDQ + hi * 8;
  {
    uint4 raw[6]; float ss = 0.f;
#pragma unroll
    for (int d0 = 0; d0 < 6; ++d0) { raw[d0] = *reinterpret_cast<const uint4*>(Qw + d0 * 16); float t8[8]; unpack8(raw[d0], t8);
#pragma unroll
      for (int j = 0; j < 8; ++j) ss += t8[j] * t8[j]; }
    ss += __shfl_xor(ss, 32);
    const float rstd = rsqrtf(ss / 96.0f + EPS);
    const int spos = s0 + wid * 32 + r32;
#pragma unroll
    for (int d0 = 0; d0 < 6; ++d0) {
      float t8[8]; unpack8(raw[d0], t8);
      const float4 g0 = *(const float4*)(gq + d0 * 16 + hi * 8), g1 = *(const float4*)(gq + d0 * 16 + hi * 8 + 4);
      t8[0] *= rstd * g0.x; t8[1] *= rstd * g0.y; t8[2] *= rstd * g0.z; t8[3] *= rstd * g0.w; t8[4] *= rstd * g1.x; t8[5] *= rstd * g1.y; t8[6] *= rstd * g1.z; t8[7] *= rstd * g1.w;
      if (d0 >= 4) {
        const int pos = (d0 == 5) ? (spos & 63) : (spos >> 6);
#pragma unroll
        for (int j = 0; j < 8; ++j) {
          const float2 cs = *(const float2*)(rope + (pos * 8 + j) * 2);
          const float mine = t8[j], other = __shfl_xor(mine, 32);
          t8[j] = hi ? (mine * cs.x + other * cs.y) : (mine * cs.x - other * cs.y);
        }
      }
      const uint4 w = pack8(t8); qr[d0] = *reinterpret_cast<const bf16x8*>(&w);
      __builtin_amdgcn_sched_barrier(0);
    }
  }
  const bool k1on = tid < 256;
  const int kc0 = tid, kc1 = 512 + tid;
  const int kst0 = (kc0 / 12) * KROW + (kc0 % 12) * 16, kst1 = (kc1 / 12) * KROW + (kc1 % 12) * 16;
  const int vst0 = v_st(tid >> 3, (tid & 7) * 8);
  const int vb0 = (int)(uintptr_t)V_lds + v_rd_base(lane);
  struct { bf16x8 vs0, ks0, ks1; } sr_[2];
#define ATT_SLOAD(i, k0) do { sr_[i].vs0 = *reinterpret_cast<const bf16x8*>(Vh + (long)(k0) * 64 + tid * 8); \
    sr_[i].ks0 = *reinterpret_cast<const bf16x8*>(Kh + (long)(k0) * 96 + kc0 * 8); \
    if (k1on) sr_[i].ks1 = *reinterpret_cast<const bf16x8*>(Kh + (long)(k0) * 96 + kc1 * 8); } while (0)
#define ATT_SWRITE(b, i) do { *(bf16x8*)(V_lds + (b) * SHM_V + vst0) = sr_[i].vs0; \
    *(bf16x8*)(K_lds + (b) * SHM_K + kst0) = sr_[i].ks0; \
    if (k1on) *(bf16x8*)(K_lds + (b) * SHM_K + kst1) = sr_[i].ks1; } while (0)
#define ATT_SWAIT() asm volatile("s_waitcnt vmcnt(3)" ::: "memory")
#define ATT_RESC(a) do { if (__any((a) < 1.f)) { if (hi == 0) al_l[r32] = (a); asm volatile("s_waitcnt lgkmcnt(0)" ::: "memory"); \
    _Pragma("unroll") for (int d = 0; d < 3; ++d) _Pragma("unroll") for (int r = 0; r < 16; ++r) o[d][r] *= al_l[crow(r, hi)]; } } while (0)
  f32x16 pA0, pA1, pB0, pB1; float mnA, mnB, alA, alB; bf16x8 pa0, pa1, pa2, pa3; const int NT = seq / 64;
  constexpr int SE = 0, SO = 1;
  __syncthreads();
  ATT_SLOAD(SE, 0); asm volatile("s_waitcnt vmcnt(0)" ::: "memory"); ATT_SWRITE(0, SE); __syncthreads();
  qkt(pA0, pA1, K_lds, qr, r32, hi); partialSM(pA0, pA1, m_reg, mnA, alA);
  ATT_SLOAD(SO, 64); if (2 < NT) ATT_SLOAD(SE, 128);
  ATT_SWAIT(); ATT_SWRITE(1, SO); __syncthreads();
  for (int j = 1; j + 1 < NT; j += 2) {
    ATT_SBAR(); qkt(pB0, pB1, K_lds + SHM_K, qr, r32, hi);
    finishSM(pA0, pA1, alA, l_reg, pa0, pa1, pa2, pa3); ATT_SBAR();
    ATT_SLOAD(SO, (j + 2) * 64); ATT_SBAR();
    pv_d0(o, vb0, pa0, pa1, pa2, pa3); partialSM(pB0, pB1, m_reg, mnB, alB);
    __syncthreads(); ATT_SWAIT(); ATT_SWRITE(0, SE);
    ATT_RESC(alB); __syncthreads();
    ATT_SBAR(); qkt(pA0, pA1, K_lds, qr, r32, hi);
    finishSM(pB0, pB1, alB, l_reg, pa0, pa1, pa2, pa3); ATT_SBAR();
    if (j + 3 < NT) ATT_SLOAD(SE, (j + 3) * 64); ATT_SBAR();
    pv_d0(o, vb0 + SHM_V, pa0, pa1, pa2, pa3); partialSM(pA0, pA1, m_reg, mnA, alA);
    __syncthreads(); ATT_SWAIT(); ATT_SWRITE(1, SO);
    ATT_RESC(alA); __syncthreads();
  }
  ATT_SBAR(); qkt(pB0, pB1, K_lds + SHM_K, qr, r32, hi);
  finishSM(pA0, pA1, alA, l_reg, pa0, pa1, pa2, pa3); ATT_SBAR();
  pv_d0(o, vb0, pa0, pa1, pa2, pa3); partialSM(pB0, pB1, m_reg, mnB, alB);
  __syncthreads(); ATT_RESC(alB);
  finishSM(pB0, pB1, alB, l_reg, pa0, pa1, pa2, pa3); ATT_SBAR();
  pv_d0(o, vb0 + SHM_V, pa0, pa1, pa2, pa3);
  (void)li_l;
  float rli[16];
#pragma unroll
  for (int r = 0; r < 16; ++r) rli[r] = __builtin_amdgcn_rcpf(o[2][r]);
  bf16_t* Ow = Ob + (long)(wid * 32) * LDO;
#pragma unroll
  for (int r = 0; r < 16; ++r) { const int orow = crow(r, hi);
#pragma unroll
    for (int d0 = 0; d0 < 2; ++d0) Ow[(long)orow * LDO + d0 * 32 + r32] = f2bf(o[d0][r] * rli[r]); }
#undef ATT_SLOAD
#undef ATT_SWRITE
#undef ATT_SWAIT
#undef ATT_RESC
}
}

__device__ __forceinline__ void ph_attn_mfma(char* lds, const bf16_t* __restrict__ Q, const bf16_t* __restrict__ Kb, const bf16_t* __restrict__ Vb, bf16_t* __restrict__ mixin,
                                             const float* __restrict__ g_qk_q, const float* __restrict__ rope) {
    for (int unit = blockIdx.x; unit < NB * NH * 8; unit += gridDim.x) {
        const int xcd = unit & 7, slot = (unit >> 3) & 31, jj = unit >> 8;
        const int bh = xcd + 8 * ((slot >> 3) + 4 * jj), qblk = slot & 7, b = bh >> 3, h = bh & 7;
        att::attn_body(Q + ((size_t)(b * S + qblk * 256) * NH + h) * 96, Kb + (size_t)bh * SKV * 96, Vb + (size_t)bh * SKV * 64,
                       mixin + (size_t)(b * S + qblk * 256) * 1024 + 512 + h * 64, SKV, lds, g_qk_q, rope, qblk * 256);
    }
}


typedef float f32x2_t __attribute__((ext_vector_type(2)));


__device__ __forceinline__ void ph_cvt8n(const Ctx& cx, const float* __restrict__ pu, const float* __restrict__ pv, unsigned char* __restrict__ u4, unsigned char* __restrict__ v8,
                                         float* __restrict__ su, float* __restrict__ sv) {
    for (int r = cx.gwave; r < 2 * 16384; r += cx.nwave) {
        const bool isu = r < 16384; const int rr = isu ? r : r - 16384;
        const float* src = (isu ? pu : pv) + (size_t)rr * D + cx.lane * 16;
        float4 v[4]; float mx = 0.f;
#pragma unroll
        for (int i = 0; i < 4; ++i) { v[i] = *(const float4*)(src + i * 4); mx = fmaxf(mx, fmaxf(fmaxf(fabsf(v[i].x), fabsf(v[i].y)), fmaxf(fabsf(v[i].z), fabsf(v[i].w)))); }
        mx = wave_max(mx);
        if (isu) {
            const float s = mx > 0.f ? mx * 0.1f : 1.0f, inv = 1.0f / s;
            unsigned w0 = 0u, w1 = 0u;
            const float xs[16] = {v[0].x, v[0].y, v[0].z, v[0].w, v[1].x, v[1].y, v[1].z, v[1].w, v[2].x, v[2].y, v[2].z, v[2].w, v[3].x, v[3].y, v[3].z, v[3].w};
#pragma unroll
            for (int k = 0; k < 8; ++k) {
                int q0 = (int)rintf(xs[k] * inv), q1 = (int)rintf(xs[8 + k] * inv);
                q0 = q0 < -8 ? -8 : (q0 > 7 ? 7 : q0); q1 = q1 < -8 ? -8 : (q1 > 7 ? 7 : q1);
                w0 |= ((unsigned)q0 & 0xFu) << (4 * k); w1 |= ((unsigned)q1 & 0xFu) << (4 * k);
            }
            *(uint2*)(u4 + (size_t)(cx.lane >> 4) * (16384 * 128) + (size_t)rr * 128 + (cx.lane & 15) * 8) = make_uint2(w0, w1);
            if (cx.lane == 0) su[2 * rr] = s;
        } else {
            const float s = mx > 0.f ? mx * (0.85f / 6.0f) : 1.0f, inv = 1.0f / s;
            unsigned w0 = 0u, w1 = 0u;
            w0 = __builtin_amdgcn_cvt_scalef32_pk_fp4_f32(w0, v[0].x * inv, v[0].y * inv, 1.0f, 0); w0 = __builtin_amdgcn_cvt_scalef32_pk_fp4_f32(w0, v[0].z * inv, v[0].w * inv, 1.0f, 1);
            w0 = __builtin_amdgcn_cvt_scalef32_pk_fp4_f32(w0, v[1].x * inv, v[1].y * inv, 1.0f, 2); w0 = __builtin_amdgcn_cvt_scalef32_pk_fp4_f32(w0, v[1].z * inv, v[1].w * inv, 1.0f, 3);
            w1 = __builtin_amdgcn_cvt_scalef32_pk_fp4_f32(w1, v[2].x * inv, v[2].y * inv, 1.0f, 0); w1 = __builtin_amdgcn_cvt_scalef32_pk_fp4_f32(w1, v[2].z * inv, v[2].w * inv, 1.0f, 1);
            w1 = __builtin_amdgcn_cvt_scalef32_pk_fp4_f32(w1, v[3].x * inv, v[3].y * inv, 1.0f, 2); w1 = __builtin_amdgcn_cvt_scalef32_pk_fp4_f32(w1, v[3].z * inv, v[3].w * inv, 1.0f, 3);
            *(uint2*)(v8 + (size_t)(cx.lane >> 4) * (16384 * 128) + (size_t)rr * 128 + (cx.lane & 15) * 8) = make_uint2(w0, w1);
            if (cx.lane == 0) su[2 * rr + 1] = s;
        }
    }
}
#define LDI(ptr, idx) (*(const int*)((const char*)(ptr) + (unsigned)((idx) * 4)))
#define LDF(ptr, idx) (*(const float*)((const char*)(ptr) + (unsigned)((idx) * 4)))
#define LDU4(ptr, byteoff) (*(const uint4*)((const char*)(ptr) + (unsigned)(byteoff)))
__device__ __forceinline__ void ph_peer_u(const Ctx& cx, int rk, int nloc, int ti, int nteam, const unsigned* __restrict__ hqn, const float* __restrict__ hs, const int* __restrict__ eidx, const unsigned char* __restrict__ u4, float* __restrict__ pa) {
    const int lane = cx.lane, p = lane >> 3, q = lane & 7;
    for (int item = ti; item < 8; item += nteam) {
        const int c = item & 3, hf = item >> 2;
        const int ts = nloc * 16, tb = 2 * (rk * 8 + cx.wib) + hf;
        const int n = tb < T ? (T - 1 - tb) / ts + 1 : 0;
        if (n == 0) continue;
        const int tlast = tb + (n - 1) * ts;
        const unsigned hoff = (unsigned)((c * 32 + q * 4) * 4);
        const unsigned toff = (unsigned)(c * (16384 * 128) + q * 16);
        uint4 rows[16];
        const int t0 = tb, t1 = n > 1 ? tb + ts : tlast;
        int id0c = LDI(eidx, t0 * 128 + lane), id1c = LDI(eidx, t0 * 128 + 64 + lane);
        uint4 hhc = LDU4(hqn, t0 * 1024 + (int)hoff), hlc = LDU4(hqn, t0 * 1024 + 512 + (int)hoff); float shc = LDF(hs, t0);
        int id0n = LDI(eidx, t1 * 128 + lane), id1n = LDI(eidx, t1 * 128 + 64 + lane);
        uint4 hhn = LDU4(hqn, t1 * 1024 + (int)hoff), hln = LDU4(hqn, t1 * 1024 + 512 + (int)hoff); float shn = LDF(hs, t1);
#pragma unroll
        for (int r = 0; r < 16; ++r) { const int id = __shfl(r < 8 ? id0c : id1c, ((r * 8) & 63) + p); rows[r] = *(const uint4*)(u4 + ((unsigned)id * 128u + toff)); }
        for (int i = 0; i < n; ++i) {
            const int tcur = tb + i * ts;
            const int t2 = (i + 2 < n) ? tb + (i + 2) * ts : tlast;
            const int id0f = LDI(eidx, t2 * 128 + lane), id1f = LDI(eidx, t2 * 128 + 64 + lane);
            const uint4 hhf = LDU4(hqn, t2 * 1024 + (int)hoff), hlf4 = LDU4(hqn, t2 * 1024 + 512 + (int)hoff); const float shf = LDF(hs, t2);
            unsigned roffs[16];
#pragma unroll
            for (int r = 0; r < 16; ++r) roffs[r] = (unsigned)__shfl(r < 8 ? id0n : id1n, (r & 7) * 8 + p) * 128u + toff;
            float o0 = 0.f, o1 = 0.f;
#pragma unroll
            for (int r = 0; r < 16; ++r) {
                int ah = 0, al = 0;
                ah = __builtin_amdgcn_sdot8((int)rows[r].x, (int)hhc.x, ah, false); al = __builtin_amdgcn_sdot8((int)rows[r].x, (int)hlc.x, al, false);
                ah = __builtin_amdgcn_sdot8((int)rows[r].y, (int)hhc.y, ah, false); al = __builtin_amdgcn_sdot8((int)rows[r].y, (int)hlc.y, al, false);
                ah = __builtin_amdgcn_sdot8((int)rows[r].z, (int)hhc.z, ah, false); al = __builtin_amdgcn_sdot8((int)rows[r].z, (int)hlc.z, al, false);
                ah = __builtin_amdgcn_sdot8((int)rows[r].w, (int)hhc.w, ah, false); al = __builtin_amdgcn_sdot8((int)rows[r].w, (int)hlc.w, al, false);
                const float d = sum8_dpp((float)(ah * 16 + al));
                if (q == (r & 7)) { if (r < 8) o0 = d; else o1 = d; }
                rows[r] = *(const uint4*)(u4 + roffs[r]);
            }
            *(float*)((char*)(pa + (size_t)c * T * 128) + (unsigned)((tcur * 128 + q * 8 + p) * 4)) = o0 * shc;
            *(float*)((char*)(pa + (size_t)c * T * 128) + (unsigned)((tcur * 128 + 64 + q * 8 + p) * 4)) = o1 * shc;
            id0n = id0f; id1n = id1f; hhc = hhn; hlc = hln; shc = shn; hhn = hhf; hln = hlf4; shn = shf;
        }
    }
}
typedef float f32x2q_t __attribute__((ext_vector_type(2)));
struct R4In { int4 e0, e1; float4 p[4][2]; float4 g0, g1; };
__device__ __forceinline__ void r4_load(R4In& in, int it8, const float* __restrict__ pa, const int* __restrict__ eidx, const float* __restrict__ gates) {
    const int base = it8 * 8;
    in.e0 = *(const int4*)(eidx + base); in.e1 = *(const int4*)(eidx + base + 4);
#pragma unroll
    for (int x = 0; x < 4; ++x) { in.p[x][0] = *(const float4*)(pa + (size_t)x * T * 128 + base); in.p[x][1] = *(const float4*)(pa + (size_t)x * T * 128 + base + 4); }
    in.g0 = *(const float4*)(gates + base); in.g1 = *(const float4*)(gates + base + 4);
}
__device__ __forceinline__ void r4_scales(const R4In& in, const float* ssv, float2 (&sc)[8]) {
    const int ee[8] = {in.e0.x, in.e0.y, in.e0.z, in.e0.w, in.e1.x, in.e1.y, in.e1.z, in.e1.w};
#pragma unroll
    for (int k = 0; k < 8; ++k) sc[k] = *(const float2*)(ssv + 2 * ee[k]);
}
__device__ __forceinline__ void r4_finish(const R4In& in, const float2 (&sc)[8], int it8, unsigned* __restrict__ abuf, float* __restrict__ s0buf) {
    float aa[8] = {0.f, 0.f, 0.f, 0.f, 0.f, 0.f, 0.f, 0.f};
#pragma unroll
    for (int x = 0; x < 4; ++x) { aa[0] += in.p[x][0].x; aa[1] += in.p[x][0].y; aa[2] += in.p[x][0].z; aa[3] += in.p[x][0].w; aa[4] += in.p[x][1].x; aa[5] += in.p[x][1].y; aa[6] += in.p[x][1].z; aa[7] += in.p[x][1].w; }
    const float gg[8] = {in.g0.x, in.g0.y, in.g0.z, in.g0.w, in.g1.x, in.g1.y, in.g1.z, in.g1.w};
    float cc[8]; float mx = 0.f;
#pragma unroll
    for (int k = 0; k < 8; ++k) { const float a = aa[k] * sc[k].x; const float act = 0.5f * a * (1.0f + erff(a * 0.70710678118654752f)); cc[k] = gg[k] * act * sc[k].y; mx = fmaxf(mx, fabsf(cc[k])); }
    mx = fmaxf(mx, __shfl_xor(mx, 1)); mx = fmaxf(mx, __shfl_xor(mx, 2)); mx = fmaxf(mx, __shfl_xor(mx, 4)); mx = fmaxf(mx, __shfl_xor(mx, 8));
    const float s0 = mx > 0.f ? mx * (1.0f / 6.0f) : 1.0f, inv = 1.0f / s0;
    unsigned w[4] = {0u, 0u, 0u, 0u};
#define R4_PAIR(PR) do { float ra = cc[2 * (PR)] * inv, rb = cc[2 * (PR) + 1] * inv; \
        _Pragma("unroll") for (int tI = 0; tI < 4; ++tI) { \
            w[tI] = __builtin_amdgcn_cvt_scalef32_pk_fp4_f32(w[tI], ra, rb, 1.0f, PR); \
            const f32x2q_t d = __builtin_amdgcn_cvt_scalef32_pk_f32_fp4(w[tI], 1.0f, PR); \
            ra = (ra - d[0]) * 4.0f; rb = (rb - d[1]) * 4.0f; } } while (0)
    R4_PAIR(0); R4_PAIR(1); R4_PAIR(2); R4_PAIR(3);
#undef R4_PAIR
    const int t = it8 >> 4, j8 = it8 & 15;
#pragma unroll
    for (int tI = 0; tI < 4; ++tI) abuf[(t * 4 + tI) * 16 + j8] = w[tI];
    if (j8 == 0) s0buf[t] = s0;
}
__device__ __forceinline__ void ph_peer_r4(const Ctx& cx, char* lds, const float* __restrict__ pa, const int* __restrict__ eidx, const float* __restrict__ gates, const float* __restrict__ ssv_g,
                                           unsigned* __restrict__ abuf, float* __restrict__ s0buf) {
    __syncthreads();
    for (int e = cx.tid; e < 16384 * 2 / 4; e += NTHR) *(float4*)(lds + e * 16) = *(const float4*)(ssv_g + e * 4);
    __syncthreads();
    const float* ssv = (const float*)lds;
    for (int it8 = cx.gthr; it8 < T * 16; it8 += 2 * cx.nthr) {
        const int itB = it8 + cx.nthr; const bool hasB = itB < T * 16;
        R4In A, B; float2 sA[8], sB[8];
        r4_load(A, it8, pa, eidx, gates); r4_load(B, hasB ? itB : it8, pa, eidx, gates);
        r4_scales(A, ssv, sA); r4_scales(B, ssv, sB);
        r4_finish(A, sA, it8, abuf, s0buf);
        if (hasB) r4_finish(B, sB, itB, abuf, s0buf);
    }
    __syncthreads();
}
template <int OFF> __device__ __forceinline__ uint2 tr4_read(int vb) { uint2 r; asm volatile("ds_read_b64_tr_b4 %0, %1 offset:%2" : "=&v"(r) : "v"(vb), "i"(OFF) : "memory"); return r; }
typedef int i32x8v_t __attribute__((ext_vector_type(8)));
typedef float f32x4v_t __attribute__((ext_vector_type(4)));
__device__ __forceinline__ void ph_peer_v4(const Ctx& cx, char* lds, int rk, int nloc, int ti, int nteam, const int* __restrict__ eidx, const unsigned* __restrict__ abuf, const float* __restrict__ s0buf,
                                           const unsigned char* __restrict__ v4, const float* __restrict__ mod, const float* __restrict__ xin, const bf16_t* __restrict__ mixb, float* __restrict__ out) {
    const int lane = cx.lane, p = lane >> 3, q = lane & 7;
    const int m = lane & 15, g = lane >> 4, grp = m >> 2;
    char* wl = lds + cx.wib * 16384;
    float* ybuf = (float*)(lds + 131072 + cx.wib * 1024);
    const int rb = (int)(uintptr_t)wl + (32 * g + m) * 128, xs = m >> 1;
    const int wo_e = p * 128 + ((q ^ (p >> 1)) << 4), wo_o = p * 128 + ((q ^ (4 + (p >> 1))) << 4);
    const unsigned aoff = (unsigned)(((m & 3) * 16 + g * 4) * 4);
    for (int item = ti; item < 8; item += nteam) {
        const int c = item & 3, hf = item >> 2;
        const int ts = nloc * 16, tb = 2 * (rk * 8 + cx.wib) + hf;
        const int n = tb < T ? (T - 1 - tb) / ts + 1 : 0;
        if (n == 0) continue;
        const int tlast = tb + (n - 1) * ts;
        const unsigned toff = (unsigned)(c * (16384 * 128) + q * 16);
        const int col = c * 256 + lane * 4;
        uint4 rows[16];
        const int t0 = tb, t1 = n > 1 ? tb + ts : tlast;
        int id0c = LDI(eidx, t0 * 128 + lane), id1c = LDI(eidx, t0 * 128 + 64 + lane);
        uint4 Ac = LDU4(abuf, t0 * 256 + (int)aoff); float s0c = LDF(s0buf, t0);
        int id0n = LDI(eidx, t1 * 128 + lane), id1n = LDI(eidx, t1 * 128 + 64 + lane);
        uint4 An = LDU4(abuf, t1 * 256 + (int)aoff); float s0n = LDF(s0buf, t1);
#pragma unroll
        for (int r = 0; r < 16; ++r) { const int id = __shfl(r < 8 ? id0c : id1c, ((r * 8) & 63) + p); rows[r] = *(const uint4*)(v4 + ((unsigned)id * 128u + toff)); }
        for (int i = 0; i < n; ++i) {
            const int tcur = tb + i * ts;
            const int t2 = (i + 2 < n) ? tb + (i + 2) * ts : tlast;
            const int id0f = LDI(eidx, t2 * 128 + lane), id1f = LDI(eidx, t2 * 128 + 64 + lane);
            const uint4 Af = LDU4(abuf, t2 * 256 + (int)aoff); const float s0f = LDF(s0buf, t2);
            f32x4v_t gvc, g1c, xc; f32x2q_t mwf;
            { const unsigned og = (unsigned)(((tcur / S) * 6144 + 5 * D + col) * 4), o1 = (unsigned)(((tcur / S) * 6144 + 2 * D + col) * 4), ox = (unsigned)((tcur * D + col) * 4), om = (unsigned)((tcur * D + col) * 2);
              asm volatile("global_load_dwordx4 %0, %1, %2" : "=v"(gvc) : "v"(og), "s"(mod) : "memory");
              asm volatile("global_load_dwordx4 %0, %1, %2" : "=v"(g1c) : "v"(o1), "s"(mod) : "memory");
              asm volatile("global_load_dwordx4 %0, %1, %2" : "=v"(xc) : "v"(ox), "s"(xin) : "memory");
              asm volatile("global_load_dwordx2 %0, %1, %2" : "=v"(mwf) : "v"(om), "s"(mixb) : "memory"); }
            unsigned roffs[16];
#pragma unroll
            for (int r = 0; r < 16; ++r) roffs[r] = (unsigned)__shfl(r < 8 ? id0n : id1n, (r & 7) * 8 + p) * 128u + toff;
            __builtin_amdgcn_sched_barrier(0);
#pragma unroll
            for (int r = 0; r < 16; ++r) {
                { const uint4 w = rows[r]; *(uint4*)(wl + r * 1024 + ((r & 1) ? wo_o : wo_e)) = make_uint4(w.x, w.y, w.z, w.w); }
                __builtin_amdgcn_sched_barrier(0);
                rows[r] = *(const uint4*)(v4 + roffs[r]);
                __builtin_amdgcn_sched_barrier(0);
            }
            i32x8v_t AgV[4];
#pragma unroll
            for (int G = 0; G < 4; ++G) AgV[G] = i32x8v_t{grp == G ? (int)Ac.x : 0, grp == G ? (int)Ac.y : 0, grp == G ? (int)Ac.z : 0, grp == G ? (int)Ac.w : 0, 0, 0, 0, 0};
#define V4_AG(G) AgV[G]
            f32x4v_t acc[4];
#pragma unroll
            for (int k = 0; k < 4; ++k) acc[k] = f32x4v_t{0.f, 0.f, 0.f, 0.f};
#define V4_VQ(QD) (rb + (((QD) ^ xs) << 4))
#define V4_RD(NB, W) tr4_read<(W) * 2048 + ((NB) & 1) * 8>(V4_VQ((NB) >> 1))
#define V4_BATCH(N0) do { \
            const uint2 l0 = V4_RD(N0, 0), h0 = V4_RD(N0, 1), l1 = V4_RD(N0 + 1, 0), h1 = V4_RD(N0 + 1, 1), l2 = V4_RD(N0 + 2, 0), h2 = V4_RD(N0 + 2, 1), l3 = V4_RD(N0 + 3, 0), h3 = V4_RD(N0 + 3, 1); \
            asm volatile("s_waitcnt lgkmcnt(0)" ::: "memory"); __builtin_amdgcn_sched_barrier(0); \
            acc[(N0) >> 2] = __builtin_amdgcn_mfma_scale_f32_16x16x128_f8f6f4(V4_AG(0), (i32x8v_t{(int)l0.x, (int)l0.y, (int)h0.x, (int)h0.y, 0, 0, 0, 0}), acc[(N0) >> 2], 4, 4, 0, 0x7F7F7F7F, 0, 0x7F7F7F7F); \
            acc[(N0) >> 2] = __builtin_amdgcn_mfma_scale_f32_16x16x128_f8f6f4(V4_AG(1), (i32x8v_t{(int)l1.x, (int)l1.y, (int)h1.x, (int)h1.y, 0, 0, 0, 0}), acc[(N0) >> 2], 4, 4, 0, 0x7F7F7F7F, 0, 0x7F7F7F7F); \
            acc[(N0) >> 2] = __builtin_amdgcn_mfma_scale_f32_16x16x128_f8f6f4(V4_AG(2), (i32x8v_t{(int)l2.x, (int)l2.y, (int)h2.x, (int)h2.y, 0, 0, 0, 0}), acc[(N0) >> 2], 4, 4, 0, 0x7F7F7F7F, 0, 0x7F7F7F7F); \
            acc[(N0) >> 2] = __builtin_amdgcn_mfma_scale_f32_16x16x128_f8f6f4(V4_AG(3), (i32x8v_t{(int)l3.x, (int)l3.y, (int)h3.x, (int)h3.y, 0, 0, 0, 0}), acc[(N0) >> 2], 4, 4, 0, 0x7F7F7F7F, 0, 0x7F7F7F7F); } while (0)
            V4_BATCH(0); V4_BATCH(4); V4_BATCH(8); V4_BATCH(12);
#undef V4_BATCH
#undef V4_RD
#undef V4_VQ
#undef V4_AG
#pragma unroll
            for (int k = 0; k < 4; ++k) ybuf[64 * k + lane] = s0c * (acc[k][0] + 0.25f * acc[k][1] + 0.0625f * acc[k][2] + 0.015625f * acc[k][3]);
            const float4 yv = *(const float4*)(ybuf + 4 * lane);
            asm volatile("s_waitcnt vmcnt(16)" : "+v"(gvc), "+v"(g1c), "+v"(xc), "+v"(mwf) :: "memory");
            const unsigned mw0 = __float_as_uint(mwf[0]), mw1 = __float_as_uint(mwf[1]);
            float4 ov = make_float4(xc[0], xc[1], xc[2], xc[3]);
            ov.x += g1c[0] * __uint_as_float(mw0 << 16); ov.y += g1c[1] * __uint_as_float(mw0 & 0xffff0000u); ov.z += g1c[2] * __uint_as_float(mw1 << 16); ov.w += g1c[3] * __uint_as_float(mw1 & 0xffff0000u);
            ov.x += gvc[0] * yv.x; ov.y += gvc[1] * yv.y; ov.z += gvc[2] * yv.z; ov.w += gvc[3] * yv.w;
            *(float4*)((char*)out + (unsigned)((tcur * D + col) * 4)) = ov;
            id0n = id0f; id1n = id1f; Ac = An; An = Af; s0c = s0n; s0n = s0f;
        }
    }
}

namespace tk {
using bf16x8 = __attribute__((ext_vector_type(8))) short;
using f32x16 = __attribute__((ext_vector_type(16))) float;
constexpr int SKROW = 272;
constexpr int SK_BYTES = 2 * 128 * SKROW;
constexpr int IDX_OFF = SK_BYTES;
__device__ __forceinline__ void ce_desc(float& a, float& b) {
    float hi, lo;
    asm("v_max_f32 %0, %1, %2" : "=v"(hi) : "v"(a), "v"(b));
    asm("v_min_f32 %0, %1, %2" : "=v"(lo) : "v"(a), "v"(b));
    a = hi; b = lo;
}
__device__ __forceinline__ float fmax_raw(float a, float b) { float r; asm("v_max_f32 %0, %1, %2" : "=v"(r) : "v"(a), "v"(b)); return r; }
__device__ __forceinline__ void sort16(float (&k)[16]) {
#define CE(i, j) ce_desc(k[i], k[j])
    CE(0,1); CE(2,3); CE(0,2); CE(1,3); CE(1,2); CE(4,5); CE(6,7); CE(4,6); CE(5,7); CE(5,6); CE(0,4); CE(2,6); CE(2,4); CE(1,5); CE(3,7); CE(3,5); CE(1,2); CE(3,4); CE(5,6); CE(8,9); CE(10,11); CE(8,10); CE(9,11); CE(9,10); CE(12,13); CE(14,15); CE(12,14); CE(13,15); CE(13,14); CE(8,12); CE(10,14); CE(10,12); CE(9,13); CE(11,15); CE(11,13); CE(9,10); CE(11,12); CE(13,14); CE(0,8); CE(4,12); CE(4,8); CE(2,10); CE(6,14); CE(6,10); CE(2,4); CE(6,8); CE(10,12); CE(1,9); CE(5,13); CE(5,9); CE(3,11); CE(7,15); CE(7,11); CE(3,5); CE(7,9); CE(11,13); CE(1,2); CE(3,4); CE(5,6); CE(7,8); CE(9,10); CE(11,12); CE(13,14);
#undef CE
}
__device__ __forceinline__ void bmerge16(float (&k)[16]) {
#pragma unroll
    for (int j = 8; j > 0; j >>= 1)
#pragma unroll
        for (int i = 0; i < 16; ++i) { const int l = i ^ j; if (l > i) ce_desc(k[i], k[l]); }
}
__device__ __forceinline__ void merge_top16(float (&a)[16], const float (&b)[16]) {
#pragma unroll
    for (int i = 0; i < 16; ++i) a[i] = fmax_raw(a[i], b[15 - i]);
    bmerge16(a);
}
__device__ __forceinline__ void half_top16(const char* sk_lds, const bf16_t* __restrict__ qrow, int p, int r32, int hi, float (&top)[16]) {
    bf16x8 qf[8];
#pragma unroll
    for (int ks = 0; ks < 8; ++ks) qf[ks] = *reinterpret_cast<const bf16x8*>(qrow + p * 128 + ks * 16 + hi * 8);
    float grp[4][16];
#pragma unroll
    for (int blk = 0; blk < 4; ++blk) {
        f32x16 acc = {};
        const char* arow = sk_lds + (p * 128 + blk * 32 + r32) * SKROW + hi * 16;
#pragma unroll
        for (int ks = 0; ks < 8; ++ks) { const bf16x8 af = *reinterpret_cast<const bf16x8*>(arow + ks * 32); acc = __builtin_amdgcn_mfma_f32_32x32x16_bf16(af, qf[ks], acc, 0, 0, 0); }
#pragma unroll
        for (int r = 0; r < 16; ++r) { const int base = blk * 32 + (r & 3) + 8 * (r >> 2); grp[blk][r] = __uint_as_float((__float_as_uint(acc[r]) & ~0x7Fu) | (unsigned)(127 - base)); }
        sort16(grp[blk]);
        __builtin_amdgcn_sched_barrier(0);
    }
    merge_top16(grp[0], grp[1]); merge_top16(grp[2], grp[3]); merge_top16(grp[0], grp[2]);
    const unsigned hx = (unsigned)hi << 2;
    float mine[16], other[16];
#pragma unroll
    for (int i = 0; i < 16; ++i) { mine[i] = __uint_as_float(__float_as_uint(grp[0][i]) ^ hx); other[i] = __shfl_xor(mine[i], 32); }
    merge_top16(mine, other);
#pragma unroll
    for (int i = 0; i < 16; ++i) top[i] = mine[i];
}
__device__ __forceinline__ float cand(const float (&v1)[16], const float (&v2)[16], int a, int b) {
    return __uint_as_float((__float_as_uint(v1[a] + v2[b]) & ~0xFFu) | (unsigned)(255 - (a * 16 + b)));
}
__device__ __forceinline__ void ph_topk_mfma(const Ctx& cx, char* lds, const bf16_t* __restrict__ qp, const float* __restrict__ sub_keys, int* __restrict__ eidx, float* __restrict__ gates) {
    __syncthreads();
    for (int e = cx.tid; e < 2 * 128 * 16; e += NTHR) {
        const int row = e >> 4, c8 = (e & 15) * 8;
        const float4 f0 = *(const float4*)(sub_keys + (size_t)row * 128 + c8), f1 = *(const float4*)(sub_keys + (size_t)row * 128 + c8 + 4);
        uint4 w; w.x = (unsigned)f2bf(f0.x) | ((unsigned)f2bf(f0.y) << 16); w.y = (unsigned)f2bf(f0.z) | ((unsigned)f2bf(f0.w) << 16);
        w.z = (unsigned)f2bf(f1.x) | ((unsigned)f2bf(f1.y) << 16); w.w = (unsigned)f2bf(f1.z) | ((unsigned)f2bf(f1.w) << 16);
        *(uint4*)(lds + row * SKROW + c8 * 2) = w;
    }
    __syncthreads();
    const int r32 = cx.lane & 31, hi = cx.lane >> 5;
    unsigned char* itab = (unsigned char*)(lds + IDX_OFF + cx.tid * 32);
    for (int unit = cx.gwave; unit < (T / 32) * 8; unit += cx.nwave) {
        const int tb = unit >> 3, h = unit & 7, t = tb * 32 + r32;
        const bf16_t* qrow = qp + (size_t)t * 2048 + h * 256;
        float k1[16], k2[16];
        half_top16(lds, qrow, 0, r32, hi, k1);
        __builtin_amdgcn_sched_barrier(0);
        half_top16(lds, qrow, 1, r32, hi, k2);
        __builtin_amdgcn_sched_barrier(0);
        float v1[16], v2[16];
        {
            unsigned nb[8];
#pragma unroll
            for (int i = 0; i < 8; ++i) nb[i] = 0u;
#pragma unroll
            for (int i = 0; i < 16; ++i) {
                const unsigned u1 = __float_as_uint(k1[i]), u2 = __float_as_uint(k2[i]);
                v1[i] = __uint_as_float(u1 & ~0x7Fu); v2[i] = __uint_as_float(u2 & ~0x7Fu);
                nb[i >> 2] |= (127u - (u1 & 0x7Fu)) << (8 * (i & 3)); nb[4 + (i >> 2)] |= (127u - (u2 & 0x7Fu)) << (8 * (i & 3));
            }
            *(uint4*)(itab) = make_uint4(nb[0], nb[1], nb[2], nb[3]); *(uint4*)(itab + 16) = make_uint4(nb[4], nb[5], nb[6], nb[7]);
        }
        float A[16], Bq[16], Cq[16], Dq[16];
#pragma unroll
        for (int b = 0; b < 16; ++b) A[b] = cand(v1, v2, 0, b);
#pragma unroll
        for (int b = 0; b < 8; ++b) Bq[b] = cand(v1, v2, 1, b);
#pragma unroll
        for (int i = 0; i < 8; ++i) Bq[8 + i] = cand(v1, v2, 15 - i, 0);
        bmerge16(Bq);
        __builtin_amdgcn_sched_barrier(0);
        merge_top16(A, Bq);
        __builtin_amdgcn_sched_barrier(0);
        Cq[0] = cand(v1, v2, 2, 0); Cq[1] = cand(v1, v2, 2, 1); Cq[2] = cand(v1, v2, 2, 2); Cq[3] = cand(v1, v2, 2, 3); Cq[4] = cand(v1, v2, 2, 4);
        Cq[5] = cand(v1, v2, 3, 0); Cq[6] = cand(v1, v2, 3, 1); Cq[7] = cand(v1, v2, 3, 2); Cq[8] = cand(v1, v2, 3, 3);
        Cq[9] = cand(v1, v2, 4, 0); Cq[10] = cand(v1, v2, 4, 1); Cq[11] = cand(v1, v2, 4, 2);
        Cq[12] = cand(v1, v2, 5, 0); Cq[13] = cand(v1, v2, 5, 1); Cq[14] = cand(v1, v2, 6, 0); Cq[15] = cand(v1, v2, 6, 1);
        sort16(Cq);
        __builtin_amdgcn_sched_barrier(0);
        Dq[0] = cand(v1, v2, 7, 0); Dq[1] = cand(v1, v2, 7, 1);
        ce_desc(Dq[0], Dq[1]);
#pragma unroll
        for (int i = 2; i < 16; ++i) Dq[i] = -INFINITY;
        merge_top16(Cq, Dq);
        __builtin_amdgcn_sched_barrier(0);
        merge_top16(A, Cq);
        int eo[16]; float tv[16]; float sum = 0.f;
#pragma unroll
        for (int i = 0; i < 16; ++i) {
            const unsigned u = __float_as_uint(A[i]); const unsigned pos = 255u - (u & 0xFFu);
            eo[i] = (int)itab[pos >> 4] * 128 + (int)itab[16 + (pos & 15)];
            tv[i] = __uint_as_float(u & ~0xFFu);
        }
        const float tmx = tv[0];
#pragma unroll
        for (int i = 0; i < 16; ++i) { tv[i] = __expf(tv[i] - tmx); sum += tv[i]; }
        const float inv = 1.0f / sum;
        if (hi == 0) {
            int* ep = eidx + (size_t)t * 128 + h * 16;
#pragma unroll
            for (int i = 0; i < 4; ++i) *(int4*)(ep + i * 4) = make_int4(eo[i * 4], eo[i * 4 + 1], eo[i * 4 + 2], eo[i * 4 + 3]);
        } else {
            float* gp = gates + (size_t)t * 128 + h * 16;
#pragma unroll
            for (int i = 0; i < 4; ++i) *(float4*)(gp + i * 4) = make_float4(tv[i * 4] * inv, tv[i * 4 + 1] * inv, tv[i * 4 + 2] * inv, tv[i * 4 + 3] * inv);
        }
    }
}
}


__device__ __forceinline__ void ph_fold(const Ctx& cx, char* lds, const float* __restrict__ pool_w, const float* __restrict__ pool_scale, const float* __restrict__ w_out, bf16_t* __restrict__ wt_out) {
    float (*P)[132] = (float (*)[132])lds;
    float (*Wn)[16] = (float (*)[16])(lds + 128 * 132 * 4);
    const int tid = cx.tid;
    for (int item = blockIdx.x; item < 4 * 64; item += gridDim.x) {
        const int g = item >> 6, nt = item & 63;
        __syncthreads();
#pragma unroll
        for (int i = 0; i < 8; ++i) {
            const int e = tid + 512 * i, c = e >> 5, j4 = (e & 31) * 4;
            const float4 pw = *(const float4*)(pool_w + ((size_t)g * 128 + c) * 128 + j4);
            const float4 ps = *(const float4*)(pool_scale + g * 128 + j4);
            *(float4*)&P[c][j4] = make_float4(pw.x * ps.x, pw.y * ps.y, pw.z * ps.z, pw.w * ps.w);
        }
        { const int j = tid >> 2, n4 = (tid & 3) * 4;
          *(float4*)&Wn[j][n4] = *(const float4*)(w_out + (size_t)(g * 128 + j) * 1024 + nt * 16 + n4); }
        __syncthreads();
        const int c4 = tid >> 4, n = tid & 15;
        float a0 = 0.f, a1 = 0.f, a2 = 0.f, a3 = 0.f;
#pragma unroll 8
        for (int j = 0; j < 128; j += 4) {
            const float4 p0 = *(const float4*)&P[4 * c4][j], p1 = *(const float4*)&P[4 * c4 + 1][j], p2 = *(const float4*)&P[4 * c4 + 2][j], p3 = *(const float4*)&P[4 * c4 + 3][j];
            const float w0 = Wn[j][n], w1 = Wn[j + 1][n], w2 = Wn[j + 2][n], w3 = Wn[j + 3][n];
            a0 = fmaf(p0.x, w0, a0); a0 = fmaf(p0.y, w1, a0); a0 = fmaf(p0.z, w2, a0); a0 = fmaf(p0.w, w3, a0);
            a1 = fmaf(p1.x, w0, a1); a1 = fmaf(p1.y, w1, a1); a1 = fmaf(p1.z, w2, a1); a1 = fmaf(p1.w, w3, a1);
            a2 = fmaf(p2.x, w0, a2); a2 = fmaf(p2.y, w1, a2); a2 = fmaf(p2.z, w2, a2); a2 = fmaf(p2.w, w3, a2);
            a3 = fmaf(p3.x, w0, a3); a3 = fmaf(p3.y, w1, a3); a3 = fmaf(p3.z, w2, a3); a3 = fmaf(p3.w, w3, a3);
        }
        *(uint2*)(wt_out + (size_t)(nt * 16 + n) * 1024 + g * 128 + 4 * c4) = make_uint2((unsigned)f2bf(a0) | ((unsigned)f2bf(a1) << 16), (unsigned)f2bf(a2) | ((unsigned)f2bf(a3) << 16));
    }
    __syncthreads();
}
__device__ __forceinline__ void ph_pm8(const Ctx& cx, const bf16_t* __restrict__ proj, bf16_t* __restrict__ mixin) {
    const int lane = cx.lane, W = 2 << (lane >> 4), hw = W >> 1;
    for (int run = cx.gwave; run < T / 16; run += cx.nwave) {
        const int t0 = run * 16, s0 = t0 & (S - 1);
        const bf16_t* base = proj + (size_t)(t0 - s0) * PLD + lane * 8;
        float sum[8];
#pragma unroll
        for (int i = 0; i < 8; ++i) sum[i] = 0.f;
        {   uint4 v[16];
#pragma unroll
            for (int k = 0; k < 16; ++k) { int j = s0 - hw + k; j = j < 0 ? 0 : (j > S - 1 ? S - 1 : j); v[k] = *(const uint4*)(base + (size_t)j * PLD); }
#pragma unroll
            for (int k = 0; k < 16; ++k) { const int j = s0 - hw + k; const float m = (k < W && j >= 0 && j < S) ? 1.0f : 0.0f; float f[8]; unpack8(v[k], f);
#pragma unroll
                for (int i = 0; i < 8; ++i) sum[i] = fmaf(m, f[i], sum[i]); }
        }
#pragma unroll
        for (int q4 = 0; q4 < 4; ++q4) {
            uint4 cv[4], av[4], sv[4];
#pragma unroll
            for (int u = 0; u < 4; ++u) { const int s = s0 + q4 * 4 + u; int ja = s + hw, js = s - hw; ja = ja > S - 1 ? S - 1 : ja; js = js < 0 ? 0 : js;
                cv[u] = *(const uint4*)(base + (size_t)s * PLD); av[u] = *(const uint4*)(base + (size_t)ja * PLD); sv[u] = *(const uint4*)(base + (size_t)js * PLD); }
#pragma unroll
            for (int u = 0; u < 4; ++u) { const int s = s0 + q4 * 4 + u;
                int lo = s - hw; if (lo < 0) lo = 0;
                int hi = s + hw; if (hi > S) hi = S;
                const float inv = 1.0f / (float)(hi - lo);
                float c[8], o[8]; unpack8(cv[u], c);
#pragma unroll
                for (int i = 0; i < 8; ++i) o[i] = sum[i] * inv - c[i];
                *(uint4*)(mixin + (size_t)(t0 + q4 * 4 + u) * 1024 + lane * 8) = pack8(o);
                const float ma = (s + hw < S) ? 1.0f : 0.0f, ms = (s - hw >= 0) ? 1.0f : 0.0f;
                float fa[8], fs[8]; unpack8(av[u], fa); unpack8(sv[u], fs);
#pragma unroll
                for (int i = 0; i < 8; ++i) sum[i] = fmaf(ma, fa[i], fmaf(-ms, fs[i], sum[i]));
            }
        }
    }
}
__device__ __forceinline__ void ph_rms2(const Ctx& cx, const bf16_t* __restrict__ proj, const float* __restrict__ g_q, const float* __restrict__ g_kv, bf16_t* __restrict__ cqn, bf16_t* __restrict__ ckvn) {
    const int lane = cx.lane;
    float gq[8], gk[8];
#pragma unroll
    for (int i = 0; i < 8; ++i) { gq[i] = lane < 48 ? g_q[lane * 8 + i] : 0.f; gk[i] = lane < 32 ? g_kv[lane * 8 + i] : 0.f; }
    for (int rb = cx.gwave * 8; rb < TA; rb += cx.nwave * 8) {
        uint4 vq[8], vk[8];
#pragma unroll
        for (int u = 0; u < 8; ++u) {
            const int r = rb + u;
            vq[u] = make_uint4(0, 0, 0, 0); vk[u] = make_uint4(0, 0, 0, 0);
            if (r < T && lane < 48) vq[u] = *(const uint4*)(proj + (size_t)r * PLD + O_CQ + lane * 8);
            if (lane < 32) vk[u] = *(const uint4*)(proj + (size_t)r * PLD + O_CKV + lane * 8);
        }
#pragma unroll
        for (int u = 0; u < 8; ++u) {
            const int r = rb + u; const bool hasq = r < T;
            float fq[8], fk[8];
            unpack8(vq[u], fq); unpack8(vk[u], fk);
            float sq = 0.f, sk = 0.f;
#pragma unroll
            for (int i = 0; i < 8; ++i) { sq += fq[i] * fq[i]; sk += fk[i] * fk[i]; }
            sq = wave_sum(sq); sk = wave_sum(sk);
            const float rq = rsqrtf(sq / (float)QL + EPS), rk = rsqrtf(sk / (float)KVL + EPS);
#pragma unroll
            for (int i = 0; i < 8; ++i) { fq[i] = fq[i] * rq * gq[i]; fk[i] = fk[i] * rk * gk[i]; }
            if (hasq && lane < 48) *(uint4*)(cqn + (size_t)r * QL + lane * 8) = pack8(fq);
            if (lane < 32) *(uint4*)(ckvn + (size_t)r * KVL + lane * 8) = pack8(fk);
        }
    }
}
__device__ __forceinline__ float sum8(float v) { return sum8_dpp(v); }
__device__ __forceinline__ void ph_kfin(const Ctx& cx, const bf16_t* __restrict__ proj, const float* __restrict__ g_qk_k, const float* __restrict__ rope, bf16_t* __restrict__ Kb) {
    const int lane = cx.lane, kq = lane >> 3, p = lane & 7;
    float gk[8], gr[8];
#pragma unroll
    for (int j = 0; j < 8; ++j) { gk[j] = g_qk_k[8 * p + j]; gr[j] = g_qk_k[64 + 8 * (p & 3) + j]; }
    constexpr int NIT = NB * NH * (SKV / 8);
    for (int it0 = cx.gwave; it0 < NIT; it0 += 4 * cx.nwave) {
        bf16_t* rec[4]; uint4 raw[4], rr[4]; int keyv[4]; bool on[4];
#pragma unroll
        for (int u = 0; u < 4; ++u) {
            const int it = it0 + u * cx.nwave; on[u] = it < NIT; const int itc = on[u] ? it : it0;
            const int bh = itc / (SKV / 8), key = (itc - bh * (SKV / 8)) * 8 + kq, b = bh >> 3;
            keyv[u] = key; rec[u] = Kb + ((size_t)bh * SKV + key) * 96;
            const int trow = key < S ? b * S + key : T + b * CTXL + (key - S);
            raw[u] = *(const uint4*)(rec[u] + 8 * p);
            rr[u] = p < 4 ? *(const uint4*)(proj + (size_t)trow * PLD + O_KR + 8 * p) : make_uint4(0u, 0u, 0u, 0u);
        }
#pragma unroll
        for (int u = 0; u < 4; ++u) {
            const int key = keyv[u]; const bool lat = key < S;
            float x[8], r[8]; unpack8(raw[u], x); unpack8(rr[u], r);
            float ss = 0.f;
#pragma unroll
            for (int j = 0; j < 8; ++j) ss += x[j] * x[j] + r[j] * r[j];
            ss = sum8(ss);
            const float rstd = rsqrtf(ss / 96.0f + EPS);
#pragma unroll
            for (int j = 0; j < 8; ++j) { x[j] *= rstd * gk[j]; r[j] *= rstd * gr[j]; }
            if (lat) {
                const int pos = (p & 2) ? (key & 63) : (key >> 6);
#pragma unroll
                for (int j = 0; j < 8; ++j) {
                    const float2 cs = *(const float2*)(rope + (pos * 8 + j) * 2);
                    const float mine = r[j], other = __shfl_xor(mine, 1);
                    r[j] = (p & 1) ? (mine * cs.x + other * cs.y) : (mine * cs.x - other * cs.y);
                }
            }
            if (on[u]) { *(uint4*)(rec[u] + 8 * p) = pack8(x); if (p < 4) *(uint4*)(rec[u] + 64 + 8 * p) = pack8(r); }
        }
    }
}

#define XB_LAS __attribute__((address_space(3)))
#define XB_TMO      128
#define XB_XCNT(j)  (256  + 64 * (j))
#define XB_XSUB(j)  (1280 + 64 * (j))
#define XB_XGEN(j)  (2304 + 64 * (j))
#define XB_TOP      3328
#define XB_TOPGEN   3392
#define XCD_BAR_WORDS 3456
#define XB_SPIN_CAP (1u << 18)
__device__ __forceinline__ unsigned xb_ld(unsigned* p)              { return __hip_atomic_load(p, __ATOMIC_RELAXED, __HIP_MEMORY_SCOPE_AGENT); }
__device__ __forceinline__ unsigned xb_add(unsigned* p, unsigned v) { return __hip_atomic_fetch_add(p, v, __ATOMIC_RELAXED, __HIP_MEMORY_SCOPE_AGENT); }
__device__ __forceinline__ unsigned xb_xcc_id() { return (unsigned)__builtin_amdgcn_s_getreg((3 << 11) | 20) & 0xFu; }
#define XB_SPIN(cond, bar) do { unsigned _sp = 0; while (cond) { __builtin_amdgcn_s_sleep(1); \
    if ((++_sp & 255u) == 0u) { if (xb_ld(&(bar)[XB_TMO])) break; if (_sp > XB_SPIN_CAP) { atomicAdd(&(bar)[XB_TMO], 1u); break; } } } } while (0)
struct XcdBarrier { unsigned* bar; unsigned x; volatile XB_LAS unsigned* st; };
__device__ __forceinline__ XcdBarrier xcd_barrier_post(unsigned* bar, volatile XB_LAS unsigned* st) {
    XcdBarrier b; b.bar = bar; b.x = xb_xcc_id(); b.st = st;
    if (threadIdx.x == 0) (void)xb_add(&bar[XB_XCNT(b.x)], 1u);
    return b;
}
__device__ __forceinline__ void xcd_barrier_complete(unsigned* bar, unsigned x, unsigned& nloc, unsigned& nx) {
    const unsigned G = gridDim.x * gridDim.y * gridDim.z;
    unsigned sum, cnt, mine, sp = 0u;
    for (;;) {
        sum = 0u; cnt = 0u; mine = 0u;
#pragma unroll
        for (unsigned j = 0; j < 16; ++j) { const unsigned c = xb_ld(&bar[XB_XCNT(j)]); sum += c; cnt += (c > 0u) ? 1u : 0u; mine = (j == x) ? c : mine; }
        if (sum == G) break;
        __builtin_amdgcn_s_sleep(1);
        if ((++sp & 255u) == 0u) { if (xb_ld(&bar[XB_TMO])) break; if (sp > XB_SPIN_CAP) { atomicAdd(&bar[XB_TMO], 1u); break; } }
    }
    nloc = mine > 0u ? mine : 1u; nx = cnt > 0u ? cnt : 1u;
}
__device__ __forceinline__ void xcd_barrier(const XcdBarrier& b) {
    asm volatile("s_waitcnt vmcnt(0)" ::: "memory");
    __syncthreads();
    if (threadIdx.x == 0) {
        unsigned* bar = b.bar;
        __builtin_amdgcn_s_waitcnt(0);
        unsigned nloc = b.st[0], nx = b.st[1];
        if (nloc == 0u) { xcd_barrier_complete(bar, b.x, nloc, nx); b.st[0] = nloc; b.st[1] = nx; }
        const unsigned old = xb_add(&bar[XB_XSUB(b.x)], 1u);
        const unsigned gen = old / nloc;
        if (old + 1u == (gen + 1u) * nloc) {
            __builtin_amdgcn_fence(__ATOMIC_RELEASE, "agent");
            asm volatile("s_waitcnt vmcnt(0)" ::: "memory");
            const unsigned og = xb_add(&bar[XB_TOP], 1u);
            const unsigned tg = og / nx;
            if (og + 1u == (tg + 1u) * nx) xb_add(&bar[XB_TOPGEN], 1u);
            else XB_SPIN(xb_ld(&bar[XB_TOPGEN]) == tg, bar);
            __builtin_amdgcn_fence(__ATOMIC_ACQUIRE, "agent");
            xb_add(&bar[XB_XGEN(b.x)], 1u);
            asm volatile("s_waitcnt vmcnt(0)" ::: "memory");
        } else {
            XB_SPIN(xb_ld(&bar[XB_XGEN(b.x)]) == gen, bar);
            __builtin_amdgcn_fence(__ATOMIC_ACQUIRE, "agent");
            asm volatile("s_waitcnt vmcnt(0)" ::: "memory");
        }
    }
    __syncthreads();
}

__device__ __forceinline__ void ph_mod2(const Ctx& cx, char* lds, const float* __restrict__ c, const float* __restrict__ c_ctx, const float* __restrict__ w_ada,
                                        const float* __restrict__ b_ada, float* __restrict__ mod, float* __restrict__ rope) {
    float* sl = (float*)lds;
    float* red = (float*)(lds + 17 * 1024 * 4);
    const int tid = cx.tid;
    if (blockIdx.x == 0 && tid < 512) { const int pos = tid >> 3, i = tid & 7; const float inv = 1.0f / powf(10000.0f, (float)i / 8.0f); const float a = (float)pos * inv; rope[2 * tid] = cosf(a); rope[2 * tid + 1] = sinf(a); }
    __syncthreads();
    {   float xv[34];
#pragma unroll
        for (int i = 0; i < 34; ++i) { const int e = tid + NTHR * i; xv[i] = (e < 16 * 1024) ? c[e] : c_ctx[e - 16 * 1024]; }
#pragma unroll
        for (int i = 0; i < 34; ++i) sl[tid + NTHR * i] = xv[i] / (1.0f + expf(-xv[i])); }
    __syncthreads();
    const int cg = tid % 6, ks = tid / 6;
    for (int cb = blockIdx.x; cb < 256; cb += gridDim.x) {
        float acc[17][4];
#pragma unroll
        for (int b = 0; b < 17; ++b) { acc[b][0] = 0.f; acc[b][1] = 0.f; acc[b][2] = 0.f; acc[b][3] = 0.f; }
        if (tid < 510) {
            float4 w[13];
#pragma unroll
            for (int i = 0; i < 13; ++i) { const int k = ks + 85 * i; w[i] = (k < 1024) ? *(const float4*)(w_ada + (size_t)k * 6144 + cb * 24 + cg * 4) : make_float4(0.f, 0.f, 0.f, 0.f); }
#pragma unroll
            for (int i = 0; i < 13; ++i) {
                const int k = (ks + 85 * i) & 1023;
#pragma unroll
                for (int b = 0; b < 17; ++b) { const float s = sl[b * 1024 + k]; acc[b][0] = fmaf(s, w[i].x, acc[b][0]); acc[b][1] = fmaf(s, w[i].y, acc[b][1]); acc[b][2] = fmaf(s, w[i].z, acc[b][2]); acc[b][3] = fmaf(s, w[i].w, acc[b][3]); }
            }
        }
#pragma unroll
        for (int rd = 0; rd < 3; ++rd) {
            const int r0 = rd * 6, nr = rd < 2 ? 6 : 5;
            __syncthreads();
            if (tid < 510) {
#pragma unroll
                for (int bb = 0; bb < 6; ++bb) if (bb < nr) *(float4*)(red + ((ks * 6 + cg) * 24 + bb * 4)) = make_float4(acc[r0 + bb][0], acc[r0 + bb][1], acc[r0 + bb][2], acc[r0 + bb][3]);
            }
            __syncthreads();
            if (tid < 6 * nr * 4) {
                const int ocg = tid / (nr * 4), rem = tid % (nr * 4), bb = rem >> 2, j = rem & 3;
                float s = 0.f;
                for (int q = 0; q < 85; ++q) s += red[(q * 6 + ocg) * 24 + bb * 4 + j];
                const int col = cb * 24 + ocg * 4 + j;
                mod[(r0 + bb) * 6144 + col] = s + b_ada[col];
            }
        }
        __syncthreads();
    }
}

__device__ __forceinline__ Ctx make_ctx() {
    Ctx c; int t = threadIdx.x; asm volatile("" : "+v"(t));
    c.tid = t; c.lane = t & 63; c.wib = t >> 6;
    c.gthr = blockIdx.x * NTHR + t; c.nthr = gridDim.x * NTHR;
    c.gwave = blockIdx.x * (NTHR / 64) + c.wib; c.nwave = gridDim.x * (NTHR / 64);
    return c;
}
__global__ void __launch_bounds__(NTHR) mega(Params p) {
    extern __shared__ __attribute__((aligned(16))) char lds[];
    cg::grid_group grid = cg::this_grid();
    Ctx cx = make_ctx();
    const float* x = p.in[0]; const float* c = p.in[1]; const float* ctx = p.in[2]; const float* c_ctx = p.in[3];
    const float* w_ada = p.in[4]; const float* b_ada = p.in[5]; const float* g_norm1 = p.in[6]; const float* w_in = p.in[7];
    const float* pool_w = p.in[8]; const float* pool_scale = p.in[9]; const float* g_q_lora = p.in[10]; const float* w_q_up = p.in[11];
    const float* g_kv_lora = p.in[12]; const float* w_kv_up = p.in[13]; const float* g_qk_q = p.in[14]; const float* g_qk_k = p.in[15];
    const float* w_out = p.in[16]; const float* g_norm2 = p.in[17]; const float* peer_w_q = p.in[18]; const float* sub_keys = p.in[19];
    const float* peer_u = p.in[20]; const float* peer_v = p.in[21];
    float* out = p.out; char* ws = p.ws;
    float* mod = (float*)(ws + WS_MOD);
    float* rope = (float*)(ws + WS_ROPE);
    bf16_t* h1 = (bf16_t*)(ws + WS_H1);
    bf16_t* proj = (bf16_t*)(ws + WS_PROJ);
    bf16_t* pm = (bf16_t*)(ws + WS_PM);
    bf16_t* cqn = (bf16_t*)(ws + WS_CQN);
    bf16_t* ckvn = (bf16_t*)(ws + WS_CKVN);
    bf16_t* kvraw = (bf16_t*)(ws + WS_KVRAW);
    bf16_t* Qb = (bf16_t*)(ws + WS_Q);
    bf16_t* Kb = (bf16_t*)(ws + WS_K);
    bf16_t* Vb = (bf16_t*)(ws + WS_V);
    bf16_t* mixin = (bf16_t*)(ws + WS_MIXIN);
    float* mixf = (float*)(ws + WS_MIXF);
    bf16_t* h2 = (bf16_t*)(ws + WS_H2);
    bf16_t* qp = (bf16_t*)(ws + WS_QP);
    int* eidx = (int*)(ws + WS_EIDX);
    float* gates = (float*)(ws + WS_GATES);

    bf16_t* wt_in = (bf16_t*)(ws + WS_WT_IN);
    bf16_t* wt_q = (bf16_t*)(ws + WS_WT_Q);
    bf16_t* wt_kv = (bf16_t*)(ws + WS_WT_KV);
    bf16_t* wt_out = (bf16_t*)(ws + WS_WT_OUT);
    bf16_t* wt_pq = (bf16_t*)(ws + WS_WT_PQ);
    unsigned char* u8 = (unsigned char*)(ws + WS_U8); unsigned char* v8 = (unsigned char*)(ws + WS_V8);
    float* su = (float*)(ws + WS_SU); float* sv = (float*)(ws + WS_SV);

    volatile XB_LAS unsigned* bst = (volatile XB_LAS unsigned*)(lds + LDS_BYTES - 16);
    if (cx.tid < 4) bst[cx.tid] = 0u;
    __syncthreads();
    volatile int* ctl = (volatile int*)(lds + LDS_BYTES - 32);
    XcdBarrier bar; bar.bar = (unsigned*)(ws + WS_BAR); bar.x = xb_xcc_id(); bar.st = bst;
    if (cx.tid == 0) ctl[0] = (int)xb_add(&bar.bar[XB_XCNT(bar.x)], 1u);

    ph_mod2(cx, lds, c, c_ctx, w_ada, b_ada, mod, rope);
    ph_wt_all(cx, lds, w_in, w_q_up, w_kv_up, w_out, peer_w_q, wt_in, wt_q, wt_kv, wt_out, wt_pq);
    ph_fold(cx, lds, pool_w, pool_scale, w_out, wt_out);
    ph_cvt8n(cx, peer_u, peer_v, u8, v8, su, sv);
    if (gridDim.y == 0x7fffu) grid.sync();
    xcd_barrier(bar); cx = make_ctx();
    if (cx.tid == 0) {
        int cntx = 0, below = 0, nxx = 0;
        for (unsigned jx = 0; jx < 16; ++jx) { const int cc = (int)xb_ld(&bar.bar[XB_XCNT(jx)]); if (cc > 0) { ++nxx; if (jx < bar.x) ++below; } if (jx == bar.x) cntx = cc; }
        ctl[1] = cntx > 0 ? cntx : 1; ctl[2] = below; ctl[3] = nxx > 0 ? nxx : 1;
    }
    __syncthreads();
    ph_h1(cx, x, ctx, g_norm1, mod, h1);
    xcd_barrier(bar); cx = make_ctx();
    run_gemm(lds, h1, wt_in, TA, PLD, D, pg8::EpiBf16{proj, PLD});
    xcd_barrier(bar); cx = make_ctx();
    ph_pm8(cx, proj, mixin);
    ph_rms2(cx, proj, g_q_lora, g_kv_lora, cqn, ckvn);
    xcd_barrier(bar); cx = make_ctx();
    run_gemm(lds, cqn, wt_q, T, 768, QL, pg8::EpiBf16{Qb, 768});
    run_gemm(lds, ckvn, wt_kv, TA, 1024, KVL, pg8::EpiKV{Kb, Vb}, true);
    xcd_barrier(bar); cx = make_ctx();
    ph_kfin(cx, proj, g_qk_k, rope, Kb);
    xcd_barrier(bar); cx = make_ctx();
    ph_attn_mfma(lds, Qb, Kb, Vb, mixin, g_qk_q, rope);
    xcd_barrier(bar); cx = make_ctx();
    bf16_t* mixb = (bf16_t*)(ws + WS_H1);
    run_gemm(lds, mixin, wt_out, T, D, D, pg8::EpiBf16{mixb, D});
    xcd_barrier(bar); cx = make_ctx();
    unsigned* hqn = (unsigned*)(ws + WS_MIXIN);
    float* hs = (float*)(ws + WS_MIXIN + (size_t)T * 1024);
    ph_h2(cx, x, mixb, mod, g_norm2, out, h2, hqn, hs);
    xcd_barrier(bar); cx = make_ctx();
    run_gemm(lds, h2, wt_pq, T, 2048, D, pg8::EpiBf16{qp, 2048});
    xcd_barrier(bar); cx = make_ctx();
    tk::ph_topk_mfma(cx, lds, qp, sub_keys, eidx, gates);
    xcd_barrier(bar); cx = make_ctx();
    float* pa = (float*)(ws + WS_Q);
    float* cbuf = (float*)(ws + WS_PM + (size_t)T * 128 * 4);
    ph_peer_u(cx, __builtin_amdgcn_readfirstlane(ctl[0]), __builtin_amdgcn_readfirstlane(ctl[1]), __builtin_amdgcn_readfirstlane(ctl[2]), __builtin_amdgcn_readfirstlane(ctl[3]), hqn, hs, eidx, u8, pa);
    xcd_barrier(bar); cx = make_ctx();
    ph_peer_r4(cx, lds, pa, eidx, gates, su, (unsigned*)cbuf, cbuf + (size_t)T * 64);
    xcd_barrier(bar); cx = make_ctx();
    ph_peer_v4(cx, lds, __builtin_amdgcn_readfirstlane(ctl[0]), __builtin_amdgcn_readfirstlane(ctl[1]), __builtin_amdgcn_readfirstlane(ctl[2]), __builtin_amdgcn_readfirstlane(ctl[3]), eidx, (const unsigned*)cbuf, cbuf + (size_t)T * 64, v8, mod, x, mixb, out);
}

extern "C" void kernel_launch(void* const* d_in, const int* in_sizes, int n_in, void* d_out, int out_size, void* d_ws, size_t ws_size, hipStream_t stream) {
    static int grid_blocks = 0;
    if (!grid_blocks) {
        int dev = 0, cus = 0, per_cu = 0;
        (void)hipGetDevice(&dev);
        (void)hipDeviceGetAttribute(&cus, hipDeviceAttributeMultiprocessorCount, dev);
        (void)hipFuncSetAttribute((const void*)mega, hipFuncAttributeMaxDynamicSharedMemorySize, LDS_BYTES);
        (void)hipOccupancyMaxActiveBlocksPerMultiprocessor(&per_cu, mega, NTHR, LDS_BYTES);
        if (per_cu < 1) per_cu = 1;
        grid_blocks = cus * per_cu;
        if (ws_size < WS_END2) fprintf(stderr, "kernel_launch: workspace too small: %zu < %zu\n", ws_size, (size_t)WS_END2);
    }
    (void)hipMemsetAsync((char*)d_ws + WS_BAR, 0, XCD_BAR_WORDS * 4, stream);
    Params p{};
    for (int i = 0; i < 22; ++i) p.in[i] = (const float*)d_in[i];
    p.out = (float*)d_out; p.ws = (char*)d_ws;
    void* args[] = {&p};
    hipError_t e = hipLaunchCooperativeKernel((const void*)mega, dim3(grid_blocks), dim3(NTHR), args, LDS_BYTES, stream);
    if (e != hipSuccess) fprintf(stderr, "cooperative launch failed: %s (grid %d)\n", hipGetErrorString(e), grid_blocks);
}
```

```cpp
#include <hip/hip_runtime.h>
#include <hip/hip_cooperative_groups.h>
#include <stdint.h>
#include <stdio.h>
#include <math.h>
namespace cg = cooperative_groups;

typedef unsigned short bf16_t;

constexpr int D = 1024, NB = 16, S = 2048, T = NB * S, CTXL = 256, TC = NB * CTXL, TA = T + TC;
constexpr int INW = 1184, PW = 512, QL = 384, KVL = 256, ROPE = 32, NOPE = 64, QKH = 96, VH = 64, NH = 8;
constexpr int SKV = S + CTXL;
constexpr int PLD = 1280;
constexpr int O_CQ = 512, O_CKV = 896, O_KR = 1152;
constexpr float EPS = 1e-6f;
constexpr int NTHR = 512;

constexpr size_t MB = 1024 * 1024;
constexpr size_t WS_MOD = 0;
constexpr size_t WS_ROPE = 512 * 1024;
constexpr size_t WS_BAR = 768 * 1024;
constexpr size_t WS_H1 = 1 * MB;
constexpr size_t SZ_H1 = (size_t)TA * 1024 * 2;
constexpr size_t WS_PROJ = WS_H1 + SZ_H1;
constexpr size_t SZ_PROJ = (size_t)TA * PLD * 2;
constexpr size_t WS_PM = WS_PROJ + SZ_PROJ;
constexpr size_t SZ_PM = (size_t)T * 512 * 2;
constexpr size_t WS_CQN = WS_PM + SZ_PM;
constexpr size_t SZ_CQN = (size_t)T * 384 * 2;
constexpr size_t WS_CKVN = WS_CQN + SZ_CQN;
constexpr size_t SZ_CKVN = (size_t)TA * 256 * 2;
constexpr size_t WS_Q = WS_CKVN + SZ_CKVN;
constexpr size_t SZ_Q = (size_t)T * 768 * 2;
constexpr size_t WS_K = WS_Q + SZ_Q;
constexpr size_t SZ_K = (size_t)NB * NH * SKV * 96 * 2;
constexpr size_t WS_V = WS_K + SZ_K;
constexpr size_t SZ_V = (size_t)NB * NH * SKV * 64 * 2;
constexpr size_t WS_MIXIN = WS_V + SZ_V;
constexpr size_t SZ_MIXIN = (size_t)T * 1024 * 2;
constexpr size_t WS_END = WS_MIXIN + SZ_MIXIN;
constexpr size_t WS_KVRAW = WS_H1;
constexpr size_t WS_MIXF = WS_Q;
constexpr size_t WS_H2 = WS_PROJ;
constexpr size_t WS_QP = WS_Q;
constexpr size_t WS_EIDX = WS_PM;
constexpr size_t WS_GATES = WS_CQN;
static_assert(SZ_Q + SZ_K + SZ_V >= (size_t)T * 1024 * 4, "mixf fits");
static_assert(SZ_PM >= (size_t)T * 128 * 8 && SZ_CQN >= (size_t)T * 128 * 4, "eidx+cbuf / gates fit");
static_assert(SZ_H1 >= (size_t)T * 1024 * 2, "mixb fits");
static_assert(WS_END <= 512 * MB, "workspace");

constexpr size_t WS_WT_IN = WS_END;
constexpr size_t WS_WT_Q = WS_WT_IN + (size_t)1280 * 1024 * 2;
constexpr size_t WS_WT_KV = WS_WT_Q + (size_t)768 * 384 * 2;
constexpr size_t WS_WT_OUT = WS_WT_KV + (size_t)1024 * 256 * 2;
constexpr size_t WS_WT_PQ = WS_WT_OUT + (size_t)1024 * 1024 * 2;
constexpr size_t WS_U8 = WS_WT_PQ + (size_t)2048 * 1024 * 2;
constexpr size_t WS_V8 = WS_U8 + (size_t)16384 * 1024;
constexpr size_t WS_SU = WS_V8 + (size_t)16384 * 1024;
constexpr size_t WS_SV = WS_SU + (size_t)16384 * 4;
constexpr size_t WS_END2 = WS_SV + (size_t)16384 * 4;
static_assert(WS_END2 <= 512 * MB, "workspace");

constexpr int LDS_BYTES = 144 * 1024;

__device__ __forceinline__ float bf2f(bf16_t v) { return __uint_as_float(((unsigned)v) << 16); }
__device__ __forceinline__ bf16_t f2bf(float f) { unsigned u = __float_as_uint(f); return (bf16_t)((u + 0x7fffu + ((u >> 16) & 1u)) >> 16); }
__device__ __forceinline__ float toF(float v) { return v; }
__device__ __forceinline__ float toF(bf16_t v) { return bf2f(v); }
__device__ __forceinline__ void fromF(float& d, float v) { d = v; }
__device__ __forceinline__ void fromF(bf16_t& d, float v) { d = f2bf(v); }
__device__ __forceinline__ float wave_max(float v) {
#pragma unroll
    for (int o = 32; o > 0; o >>= 1) v = fmaxf(v, __shfl_xor(v, o));
    return v;
}
__device__ __forceinline__ float wave_sum(float v) {
#pragma unroll
    for (int o = 32; o > 0; o >>= 1) v += __shfl_xor(v, o);
    return v;
}

__device__ __forceinline__ void unpack8(const uint4& v, float* f) {
    f[0] = __uint_as_float(v.x << 16); f[1] = __uint_as_float(v.x & 0xffff0000u); f[2] = __uint_as_float(v.y << 16); f[3] = __uint_as_float(v.y & 0xffff0000u);
    f[4] = __uint_as_float(v.z << 16); f[5] = __uint_as_float(v.z & 0xffff0000u); f[6] = __uint_as_float(v.w << 16); f[7] = __uint_as_float(v.w & 0xffff0000u);
}
__device__ __forceinline__ uint4 pack8(const float* f) {
    uint4 o;
    o.x = (unsigned)f2bf(f[0]) | ((unsigned)f2bf(f[1]) << 16); o.y = (unsigned)f2bf(f[2]) | ((unsigned)f2bf(f[3]) << 16);
    o.z = (unsigned)f2bf(f[4]) | ((unsigned)f2bf(f[5]) << 16); o.w = (unsigned)f2bf(f[6]) | ((unsigned)f2bf(f[7]) << 16);
    return o;
}

__device__ __forceinline__ float sum8_dpp(float d) {
    d += __int_as_float(__builtin_amdgcn_update_dpp(0, __float_as_int(d), 0xB1, 0xF, 0xF, true));
    d += __int_as_float(__builtin_amdgcn_update_dpp(0, __float_as_int(d), 0x4E, 0xF, 0xF, true));
    d += __int_as_float(__builtin_amdgcn_update_dpp(0, __float_as_int(d), 0x141, 0xF, 0xF, true));
    return d;
}

struct Params {
    const float* in[22];
    float* out;
    char* ws;
};
struct Ctx {
    int tid, lane, wib, gthr, nthr, gwave, nwave;
};

template <bool RES>
__device__ __forceinline__ void norm_mod_rows4(int lane, const float* const (&src)[4], const float* const (&md)[4], int shift_off, int scale_off, const float* __restrict__ g, bf16_t* const (&dst)[4],
                                               const bf16_t* const (&mix)[4], int gate_off, float* const (&xout)[4], unsigned* const (&hq)[4], float* const (&hsc)[4]) {
    float4 v[4][4];
#pragma unroll
    for (int u = 0; u < 4; ++u)
#pragma unroll
        for (int hlf = 0; hlf < 2; ++hlf) { v[u][hlf * 2] = *(const float4*)(src[u] + hlf * 512 + lane * 8); v[u][hlf * 2 + 1] = *(const float4*)(src[u] + hlf * 512 + lane * 8 + 4); }
    if (RES) {
        uint4 mx[4][2];
#pragma unroll
        for (int u = 0; u < 4; ++u)
#pragma unroll
            for (int hlf = 0; hlf < 2; ++hlf) mx[u][hlf] = *(const uint4*)(mix[u] + hlf * 512 + lane * 8);
#pragma unroll
        for (int u = 0; u < 4; ++u)
#pragma unroll
            for (int hlf = 0; hlf < 2; ++hlf) {
                const int col = hlf * 512 + lane * 8;
                const float4 g0 = *(const float4*)(md[u] + gate_off + col), g1 = *(const float4*)(md[u] + gate_off + col + 4);
                float m[8]; unpack8(mx[u][hlf], m);
                float4& a = v[u][hlf * 2]; float4& bq = v[u][hlf * 2 + 1];
                a.x += g0.x * m[0]; a.y += g0.y * m[1]; a.z += g0.z * m[2]; a.w += g0.w * m[3];
                bq.x += g1.x * m[4]; bq.y += g1.y * m[5]; bq.z += g1.z * m[6]; bq.w += g1.w * m[7];
                (void)xout;
            }
    }
    float4 gg[4];
#pragma unroll
    for (int hlf = 0; hlf < 2; ++hlf) { gg[hlf * 2] = *(const float4*)(g + hlf * 512 + lane * 8); gg[hlf * 2 + 1] = *(const float4*)(g + hlf * 512 + lane * 8 + 4); }
#pragma unroll
    for (int u = 0; u < 4; ++u) {
        float ss = 0.f;
#pragma unroll
        for (int i = 0; i < 4; ++i) ss += v[u][i].x * v[u][i].x + v[u][i].y * v[u][i].y + v[u][i].z * v[u][i].z + v[u][i].w * v[u][i].w;
        ss = wave_sum(ss);
        const float rstd = rsqrtf(ss / (float)D + EPS);
        float fq[16]; float amax = 0.f;
#pragma unroll
        for (int hlf = 0; hlf < 2; ++hlf) {
            const int col = hlf * 512 + lane * 8;
            const float4 s0 = *(const float4*)(md[u] + scale_off + col), s1 = *(const float4*)(md[u] + scale_off + col + 4);
            const float4 h0 = *(const float4*)(md[u] + shift_off + col), h1v = *(const float4*)(md[u] + shift_off + col + 4);
            const float4 a = v[u][hlf * 2], bq = v[u][hlf * 2 + 1], g0 = gg[hlf * 2], g1 = gg[hlf * 2 + 1];
            float f[8];
            f[0] = a.x * rstd * g0.x * (1.0f + s0.x) + h0.x; f[1] = a.y * rstd * g0.y * (1.0f + s0.y) + h0.y; f[2] = a.z * rstd * g0.z * (1.0f + s0.z) + h0.z; f[3] = a.w * rstd * g0.w * (1.0f + s0.w) + h0.w;
            f[4] = bq.x * rstd * g1.x * (1.0f + s1.x) + h1v.x; f[5] = bq.y * rstd * g1.y * (1.0f + s1.y) + h1v.y; f[6] = bq.z * rstd * g1.z * (1.0f + s1.z) + h1v.z; f[7] = bq.w * rstd * g1.w * (1.0f + s1.w) + h1v.w;
            *(uint4*)(dst[u] + col) = pack8(f);
            if (RES) {
#pragma unroll
                for (int i = 0; i < 8; ++i) { fq[hlf * 8 + i] = bf2f(f2bf(f[i])); amax = fmaxf(amax, fabsf(fq[hlf * 8 + i])); }
            }
        }
        if (RES) {
            amax = wave_max(amax);
            const float sh = amax > 0.f ? amax * (1.0f / 119.0f) : 1.0f, ish = 1.0f / sh;
#pragma unroll
            for (int hlf = 0; hlf < 2; ++hlf) {
                unsigned whi = 0u, wlo = 0u;
#pragma unroll
                for (int i = 0; i < 8; ++i) {
                    int h8 = (int)rintf(fq[hlf * 8 + i] * ish); h8 = h8 < -119 ? -119 : (h8 > 119 ? 119 : h8);
                    const int lo = ((h8 + 8) & 15) - 8, hi = (h8 - lo) >> 4;
                    whi |= ((unsigned)hi & 0xFu) << (4 * i); wlo |= ((unsigned)lo & 0xFu) << (4 * i);
                }
                hq[u][hlf * 64 + lane] = whi; hq[u][128 + hlf * 64 + lane] = wlo;
            }
            if (lane == 0) hsc[u][0] = sh;
        }
    }
}
__device__ __forceinline__ void ph_h1(const Ctx& cx, const float* __restrict__ x, const float* __restrict__ ctx, const float* __restrict__ g, const float* __restrict__ mod, bf16_t* __restrict__ h1) {
    for (int rb = cx.gwave * 4; rb < TA; rb += cx.nwave * 4) {
        const float* src[4]; const float* md[4]; bf16_t* dst[4];
#pragma unroll
        for (int u = 0; u < 4; ++u) {
            const int r = rb + u;
            if (r < T) { src[u] = x + (size_t)r * D; md[u] = mod + (r / S) * 6144; } else { src[u] = ctx + (size_t)(r - T) * D; md[u] = mod + 16 * 6144; }
            dst[u] = h1 + (size_t)r * D;
        }
        const bf16_t* nomix[4] = {nullptr, nullptr, nullptr, nullptr}; float* noout[4] = {nullptr, nullptr, nullptr, nullptr};
        unsigned* nohq[4] = {nullptr, nullptr, nullptr, nullptr}; float* nohs[4] = {nullptr, nullptr, nullptr, nullptr};
        norm_mod_rows4<false>(cx.lane, src, md, 0, D, g, dst, nomix, 0, noout, nohq, nohs);
    }
}


namespace pg8 {
#define PG8_LAS __attribute__((address_space(3)))
typedef short bf16x8 __attribute__((ext_vector_type(8)));
typedef float f32x4 __attribute__((ext_vector_type(4)));
typedef unsigned u32x4 __attribute__((ext_vector_type(4)));
constexpr int BM = 256, BK = 64, HALF = 128, HTB = HALF * BK * 2, STAGE_BYTES = 8 * HTB, NXCD = 8, WGM = 8;
__host__ __device__ __forceinline__ int lds_byte(int r, int c) { const int st = (r >> 4) * 2 + (c >> 5), rr = r & 15, cc = c & 31, ob = rr * 64 + cc * 2; return st * 1024 + (ob ^ (((ob >> 9) & 1) << 5)); }
__host__ __device__ __forceinline__ void stage_rc(int b, int& R, int& C) { const int st = b / 1024, sb = b % 1024, swz = sb ^ (((sb >> 9) & 1) << 5); R = (st >> 1) * 16 + swz / 64; C = (st & 1) * 32 + (swz % 64) / 2; }
__host__ __device__ __forceinline__ int perm32(int rho) { const int n = rho >> 4, i = rho & 15; return 8 * (i >> 2) + 4 * n + (i & 3); }
struct Unit { int pm, pn; };
struct Gemm { const bf16_t* A; const bf16_t* Bt; int M, N, K; };
struct StaticOrder {
    int nM, nN, nwg, G, c;
    __host__ __device__ void init(int M, int N, int G_, int c_) { nM = M / BM; nN = N / BM; nwg = nM * nN; G = G_; c = c_; }
    __host__ __device__ bool next(int i, Unit& u) const {
        const long L = (long)i * G + c; if (L >= nwg) return false;
        int wgid = (int)L; { const int q = nwg / NXCD, r = nwg % NXCD, xcd = wgid % NXCD, off = wgid / NXCD; wgid = (xcd < r ? xcd * (q + 1) : r * (q + 1) + (xcd - r) * q) + off; }
        const int nig = WGM * nN, gid = wgid / nig, fm = gid * WGM, gsz = (nM - fm) < WGM ? (nM - fm) : WGM;
        u.pm = fm + ((wgid % nig) % gsz); u.pn = (wgid % nig) / gsz; return true;
    }
    __device__ __forceinline__ void a_ready(const Unit&) const {}
    __device__ __forceinline__ void done(const Unit&) const {}
};
__device__ __forceinline__ unsigned cvt_pk_bf16(float lo, float hi) { unsigned r; asm volatile("v_cvt_pk_bf16_f32 %0, %1, %2" : "=v"(r) : "v"(lo), "v"(hi)); return r; }
struct EpiBf16 {
    static constexpr bool PERM = true, AFTER_DRAIN = false;
    bf16_t* O; int ldc;
    __device__ __forceinline__ void operator()(const f32x4 (&acc)[2][2][4][2], const Unit& u, int wr, int wc, int fr, int fq) const {
        const int row0 = u.pm * BM + wr * 64 + fr, col0 = u.pn * BM + wc * 32 + 8 * fq;
#pragma unroll
        for (int ai = 0; ai < 2; ++ai)
#pragma unroll
            for (int m = 0; m < 4; ++m) { bf16_t* rowp = O + (size_t)(row0 + ai * HALF + m * 16) * ldc + col0;
#pragma unroll
                for (int bj = 0; bj < 2; ++bj) { const f32x4 v0 = acc[ai][bj][m][0], v1 = acc[ai][bj][m][1];
                    u32x4 w; w.x = cvt_pk_bf16(v0[0], v0[1]); w.y = cvt_pk_bf16(v0[2], v0[3]); w.z = cvt_pk_bf16(v1[0], v1[1]); w.w = cvt_pk_bf16(v1[2], v1[3]);
                    *(u32x4*)(rowp + bj * HALF) = w; } }
    }
};
struct EpiKV {
    static constexpr bool PERM = true, AFTER_DRAIN = false;
    bf16_t* Kb; bf16_t* Vb;
    __device__ __forceinline__ void operator()(const f32x4 (&acc)[2][2][4][2], const Unit& u, int wr, int wc, int fr, int fq) const {
        const bool lat = u.pm < (T / BM);
        const int b = lat ? (u.pm >> 3) : (u.pm - T / BM), key0 = (lat ? (u.pm & 7) * BM : S) + wr * 64 + fr;
        const int dc = (wc & 1) * 32 + 8 * fq, rec0 = (b * NH + 2 * u.pn) * SKV + key0;
        const bool isv = wc >= 2;
        const unsigned rs2 = isv ? 128u : 192u;
        char* dst = isv ? (char*)Vb : (char*)Kb;
        unsigned off = (unsigned)rec0 * rs2 + (unsigned)dc * 2u;
#pragma unroll
        for (int ai = 0; ai < 2; ++ai)
#pragma unroll
            for (int m = 0; m < 4; ++m) {
#pragma unroll
                for (int bj = 0; bj < 2; ++bj) { const f32x4 v0 = acc[ai][bj][m][0], v1 = acc[ai][bj][m][1];
                    u32x4 w; w.x = cvt_pk_bf16(v0[0], v0[1]); w.y = cvt_pk_bf16(v0[2], v0[3]); w.z = cvt_pk_bf16(v1[0], v1[1]); w.w = cvt_pk_bf16(v1[2], v1[3]);
                    *(u32x4*)(dst + (unsigned)(off + (bj ? (unsigned)SKV * rs2 : 0u))) = w; __builtin_amdgcn_sched_barrier(0); }
                off += (m == 3 ? (unsigned)(HALF - 48) : 16u) * rs2;
                asm volatile("" : "+v"(off));
            }
    }
};
struct EpiResid {
    static constexpr bool PERM = false, AFTER_DRAIN = false;
    const float* x; const float* mod; float* out;
    __device__ __forceinline__ void operator()(const f32x4 (&acc)[2][2][4][2], const Unit& u, int wr, int wc, int fr, int fq) const {
        const int row0 = u.pm * BM + wr * 64 + fr, col0 = u.pn * BM + wc * 32 + 4 * fq;
        const float* gate = mod + (size_t)((u.pm * BM) >> 11) * 6144 + 2048;
        f32x4 gv[2][2];
#pragma unroll
        for (int bj = 0; bj < 2; ++bj)
#pragma unroll
            for (int n = 0; n < 2; ++n) gv[bj][n] = *(const f32x4*)(gate + col0 + bj * HALF + n * 16);
#pragma unroll
        for (int ai = 0; ai < 2; ++ai)
#pragma unroll
            for (int m = 0; m < 4; ++m) { const size_t off = (size_t)(row0 + ai * HALF + m * 16) * 1024 + col0;
#pragma unroll
                for (int bj = 0; bj < 2; ++bj)
#pragma unroll
                    for (int n = 0; n < 2; ++n) { const f32x4 xv = *(const f32x4*)(x + off + bj * HALF + n * 16); *(f32x4*)(out + off + bj * HALF + n * 16) = xv + gv[bj][n] * acc[ai][bj][m][n]; } }
    }
};
template <class Epi, class Sched>
__device__ __forceinline__ void gemm_phase(PG8_LAS unsigned char* lds, const Gemm g, const Sched& S, const Epi& E) {
    const int tid = threadIdx.x, wid = __builtin_amdgcn_readfirstlane(tid >> 6), lane = tid & 63, wr = wid >> 2, wc = wid & 3, fr = lane & 15, fq = lane >> 4;
    const int K = g.K, nt = K / BK;
    unsigned voffA[2], voffB[2];
#pragma unroll
    for (int i = 0; i < 2; ++i) { int R, C; stage_rc(tid * 16 + i * 8192, R, C); const int Rb = Epi::PERM ? ((R & ~31) + perm32(R & 31)) : R;
        voffA[i] = (unsigned)(R * K + C) * 2u; voffB[i] = (unsigned)(Rb * K + C) * 2u; }
    const size_t kstep = (size_t)(BK * 2);
    const size_t hstep = (size_t)HALF * K * 2;
    const size_t tstep = 2 * hstep;
    const unsigned ldsw = (unsigned)wid * 1024u;
    const int aoff = lds_byte(wr * 64 + fr, fq * 8), boff = lds_byte(wc * 32 + fr, fq * 8);
#define PG8_SA(b, h) (((b) * 2 + (h)) * HTB)
#define PG8_SB(b, h) ((4 + (b) * 2 + (h)) * HTB)
#define PG8_STAGE(bufoff, gbase, voff) do { _Pragma("unroll") for (int _i = 0; _i < 2; ++_i) \
        __builtin_amdgcn_global_load_lds((const unsigned*)((const char*)(gbase) + (voff)[_i]), (PG8_LAS unsigned*)(lds + (bufoff) + ldsw + _i * 8192), 16, 0, 0); } while (0)
#define PG8_LDA(dst, b, h) do { _Pragma("unroll") for (int m = 0; m < 4; ++m) _Pragma("unroll") for (int k = 0; k < 2; ++k) dst[m][k] = *(const PG8_LAS bf16x8*)(lds + PG8_SA(b, h) + aoff + m * 2048 + k * 1024); } while (0)
#define PG8_LDB(dst, b, h) do { _Pragma("unroll") for (int n = 0; n < 2; ++n) _Pragma("unroll") for (int k = 0; k < 2; ++k) dst[n][k] = *(const PG8_LAS bf16x8*)(lds + PG8_SB(b, h) + boff + n * 2048 + k * 1024); } while (0)
#define PG8_MMA(ai, bj, At, Bt) do { __builtin_amdgcn_s_setprio(1); _Pragma("unroll") for (int m = 0; m < 4; ++m) _Pragma("unroll") for (int n = 0; n < 2; ++n) _Pragma("unroll") for (int k = 0; k < 2; ++k) \
        acc[ai][bj][m][n] = __builtin_amdgcn_mfma_f32_16x16x32_bf16(Bt[n][k], At[m][k], acc[ai][bj][m][n], 0, 0, 0); __builtin_amdgcn_s_setprio(0); } while (0)
#define PG8_WAIT_V(n) asm volatile("s_waitcnt vmcnt(" #n ")" ::: "memory")
#define PG8_WAIT_L(n) asm volatile("s_waitcnt lgkmcnt(" #n ")" ::: "memory")
#define PG8_BAR __builtin_amdgcn_s_barrier()
#define PG8_SCHED __builtin_amdgcn_sched_barrier(0)
    Unit cur, nxt; int ui = 0;
    if (!S.next(0, cur)) return;
    f32x4 acc[2][2][4][2];
#pragma unroll
    for (int a = 0; a < 2; ++a)
#pragma unroll
        for (int b = 0; b < 2; ++b)
#pragma unroll
            for (int m = 0; m < 4; ++m)
#pragma unroll
                for (int n = 0; n < 2; ++n) acc[a][b][m][n] = (f32x4){0.f, 0.f, 0.f, 0.f};
    bf16x8 At[4][2], B0[2][2], B1[2][2];
    const char* cA = (const char*)g.A + (size_t)cur.pm * tstep; const char* cB = (const char*)g.Bt + (size_t)cur.pn * tstep;
    S.a_ready(cur);
    PG8_STAGE(PG8_SB(0, 0), cB, voffB); PG8_STAGE(PG8_SA(0, 0), cA, voffA); PG8_STAGE(PG8_SB(0, 1), cB + hstep, voffB); PG8_STAGE(PG8_SA(0, 1), cA + hstep, voffA);
    if (wr == 1) PG8_BAR;
    PG8_WAIT_V(4); PG8_BAR;
    PG8_STAGE(PG8_SB(1, 0), cB + kstep, voffB); PG8_STAGE(PG8_SA(1, 0), cA + kstep, voffA); PG8_STAGE(PG8_SB(1, 1), cB + hstep + kstep, voffB);
    PG8_WAIT_V(6); PG8_BAR;
    for (;;) {
        const bool has_next = S.next(ui + 1, nxt);
        const char* nA = has_next ? (const char*)g.A + (size_t)nxt.pm * tstep : cA; const char* nB = has_next ? (const char*)g.Bt + (size_t)nxt.pn * tstep : cB;
        for (int t = 0; t < nt; t += 2) {
            const bool last = (t == nt - 2);
            const char* a1 = cA + (size_t)(t + 1) * kstep;
            const char* a2 = last ? nA : cA + (size_t)(t + 2) * kstep; const char* b2 = last ? nB : cB + (size_t)(t + 2) * kstep;
            const char* a3 = a2 + kstep; const char* b3 = b2 + kstep;
            if (last && has_next) S.a_ready(nxt);
            PG8_LDB(B0, 0, 0); PG8_SCHED; PG8_LDA(At, 0, 0); PG8_STAGE(PG8_SA(1, 1), a1 + hstep, voffA);
            PG8_WAIT_L(8); PG8_BAR; PG8_WAIT_L(0); PG8_MMA(0, 0, At, B0); PG8_BAR; PG8_SCHED;
            PG8_LDB(B1, 0, 1); PG8_STAGE(PG8_SB(0, 0), b2, voffB);
            PG8_BAR; PG8_WAIT_L(0); PG8_MMA(0, 1, At, B1); PG8_BAR;
            PG8_LDA(At, 0, 1); PG8_STAGE(PG8_SA(0, 0), a2, voffA);
            PG8_BAR; PG8_WAIT_L(0); PG8_MMA(1, 0, At, B0); PG8_BAR; PG8_SCHED;
            PG8_STAGE(PG8_SB(0, 1), b2 + hstep, voffB);
            PG8_WAIT_V(6); PG8_BAR; PG8_MMA(1, 1, At, B1); PG8_BAR;
            PG8_LDB(B0, 1, 0); PG8_SCHED; PG8_LDA(At, 1, 0); PG8_STAGE(PG8_SA(0, 1), a2 + hstep, voffA);
            PG8_WAIT_L(8); PG8_BAR; PG8_WAIT_L(0); PG8_MMA(0, 0, At, B0); PG8_BAR; PG8_SCHED;
            PG8_LDB(B1, 1, 1); PG8_STAGE(PG8_SB(1, 0), b3, voffB);
            PG8_BAR; PG8_WAIT_L(0); PG8_MMA(0, 1, At, B1); PG8_BAR;
            PG8_LDA(At, 1, 1); PG8_STAGE(PG8_SA(1, 0), a3, voffA);
            PG8_BAR; PG8_WAIT_L(0); PG8_MMA(1, 0, At, B0); PG8_BAR; PG8_SCHED;
            PG8_STAGE(PG8_SB(1, 1), b3 + hstep, voffB);
            PG8_WAIT_V(6); PG8_BAR; PG8_MMA(1, 1, At, B1); PG8_BAR;
        }
        E(acc, cur, wr, wc, fr, fq); S.done(cur);
        if (!has_next) break;
#pragma unroll
        for (int a = 0; a < 2; ++a)
#pragma unroll
            for (int b = 0; b < 2; ++b)
#pragma unroll
                for (int m = 0; m < 4; ++m)
#pragma unroll
                    for (int n = 0; n < 2; ++n) acc[a][b][m][n] = (f32x4){0.f, 0.f, 0.f, 0.f};
        cur = nxt; cA = nA; cB = nB; ++ui;
    }
    PG8_WAIT_V(0);
    if (wr == 0) PG8_BAR;
    PG8_BAR;
#undef PG8_SA
#undef PG8_SB
#undef PG8_STAGE
#undef PG8_LDA
#undef PG8_LDB
#undef PG8_MMA
#undef PG8_WAIT_V
#undef PG8_WAIT_L
#undef PG8_BAR
#undef PG8_SCHED
}
}

template <class Epi>
__device__ __forceinline__ void run_gemm(char* lds, const bf16_t* A, const bf16_t* Bt, int M, int N, int K, const Epi& E, bool reverse = false) {
    pg8::Gemm g{A, Bt, M, N, K}; pg8::StaticOrder S; S.init(M, N, (int)gridDim.x, reverse ? (int)(gridDim.x - 1 - blockIdx.x) : (int)blockIdx.x);
    pg8::gemm_phase<Epi, pg8::StaticOrder>((PG8_LAS unsigned char*)lds, g, S, E);
}

struct WtTile { const float* W; bf16_t* Wt; int N, ldt, koff, k0, n0; };
__device__ __forceinline__ WtTile wt_pick(int tI, const float* w_in, const float* w_q_up, const float* w_kv_up, const float* w_out, const float* peer_w_q,
                                          bf16_t* wt_in, bf16_t* wt_q, bf16_t* wt_kv, bf16_t* wt_out, bf16_t* wt_pq) {
    WtTile t; int ntk, loc;
    if (tI < 320)      { t.W = w_in;     t.Wt = wt_in;  t.N = INW;  t.ldt = 1024; t.koff = 0;   ntk = 16; loc = tI; }
    else if (tI < 392) { t.W = w_q_up;   t.Wt = wt_q;   t.N = 768;  t.ldt = QL;   t.koff = 0;   ntk = 6;  loc = tI - 320; }
    else if (tI < 456) { t.W = w_kv_up;  t.Wt = wt_kv;  t.N = 1024; t.ldt = KVL;  t.koff = 0;   ntk = 4;  loc = tI - 392; }
    else if (tI < 584) { t.W = w_out + (size_t)512 * 1024; t.Wt = wt_out; t.N = 1024; t.ldt = 1024; t.koff = 512; ntk = 8; loc = tI - 456; }
    else               { t.W = peer_w_q; t.Wt = wt_pq;  t.N = 2048; t.ldt = 1024; t.koff = 0;   ntk = 16; loc = tI - 584; }
    t.k0 = (loc % ntk) * 64; t.n0 = (loc / ntk) * 64;
    return t;
}
constexpr int WT_TILES = 320 + 72 + 64 + 128 + 512;
__device__ __forceinline__ void ph_wt_all(const Ctx& cx, char* lds, const float* w_in, const float* w_q_up, const float* w_kv_up, const float* w_out, const float* peer_w_q,
                                          bf16_t* wt_in, bf16_t* wt_q, bf16_t* wt_kv, bf16_t* wt_out, bf16_t* wt_pq) {
    float (*tile)[64][65] = (float (*)[64][65])lds;
    const int G = (int)gridDim.x;
    for (int base = blockIdx.x; base < WT_TILES; base += 5 * G) {
        float v[5][8];
#pragma unroll
        for (int s5 = 0; s5 < 5; ++s5) {
            const int tI = base + s5 * G;
            if (tI < WT_TILES) {
                const WtTile t = wt_pick(tI, w_in, w_q_up, w_kv_up, w_out, peer_w_q, wt_in, wt_q, wt_kv, wt_out, wt_pq);
#pragma unroll
                for (int i = 0; i < 8; ++i) { const int e = cx.tid + 512 * i; const int kk = e >> 6, nn = e & 63; v[s5][i] = (t.n0 + nn < t.N) ? t.W[(size_t)(t.k0 + kk) * t.N + t.n0 + nn] : 0.f; }
            }
        }
        __syncthreads();
#pragma unroll
        for (int s5 = 0; s5 < 5; ++s5) {
            if (base + s5 * G < WT_TILES) {
#pragma unroll
                for (int i = 0; i < 8; ++i) { const int e = cx.tid + 512 * i; tile[s5][e >> 6][e & 63] = v[s5][i]; }
            }
        }
        __syncthreads();
#pragma unroll
        for (int s5 = 0; s5 < 5; ++s5) {
            const int tI = base + s5 * G;
            if (tI < WT_TILES) {
                const WtTile t = wt_pick(tI, w_in, w_q_up, w_kv_up, w_out, peer_w_q, wt_in, wt_q, wt_kv, wt_out, wt_pq);
#pragma unroll
                for (int i = 0; i < 4; ++i) {
                    const int e = cx.tid + 512 * i; const int nn = e >> 5, kp = e & 31;
                    *(unsigned*)(t.Wt + (size_t)(t.n0 + nn) * t.ldt + t.koff + t.k0 + 2 * kp) = (unsigned)f2bf(tile[s5][2 * kp][nn]) | ((unsigned)f2bf(tile[s5][2 * kp + 1][nn]) << 16);
                }
            }
        }
    }
    __syncthreads();
}

__device__ __forceinline__ void ph_h2(const Ctx& cx, const float* __restrict__ x, const bf16_t* __restrict__ mixb, const float* __restrict__ mod, const float* __restrict__ g2, float* __restrict__ out, bf16_t* __restrict__ h2,
                                      unsigned* __restrict__ hqn, float* __restrict__ hs) {
    for (int rb = cx.gwave * 4; rb < T; rb += cx.nwave * 4) {
        const float* src[4]; const float* md[4]; bf16_t* dst[4]; const bf16_t* mx[4]; float* xo[4]; unsigned* hq4[4]; float* hs4[4];
#pragma unroll
        for (int u = 0; u < 4; ++u) { const int r = rb + u; src[u] = x + (size_t)r * D; md[u] = mod + (r / S) * 6144; dst[u] = h2 + (size_t)r * D; mx[u] = mixb + (size_t)r * D; xo[u] = out + (size_t)r * D;
            hq4[u] = hqn + (size_t)r * 256; hs4[u] = hs + r; }
        norm_mod_rows4<true>(cx.lane, src, md, 3 * D, 4 * D, g2, dst, mx, 2 * D, xo, hq4, hs4);
    }
}

namespace att {
using bf16x8 = __attribute__((ext_vector_type(8))) short;
using s16x4  = __attribute__((ext_vector_type(4))) short;
using f32x16 = __attribute__((ext_vector_type(16))) float;
using u32x4  = __attribute__((ext_vector_type(4))) unsigned;
constexpr int KROW = 208;
constexpr int SHM_V = 64 * 64 * 2, SHM_K = 64 * KROW, SHM_ATTN = 2 * SHM_V + 2 * SHM_K + 8 * 64 * 4;
constexpr float SCALE = 0.10206207261596577f;
constexpr float THR = 8.f;
constexpr int LDQ = 768, LDO = 1024;
#define ATT_SBAR() __builtin_amdgcn_sched_barrier(0)
__device__ __forceinline__ int crow(int r, int hi) { return (r & 3) + 8 * (r >> 2) + 4 * hi; }
__device__ __forceinline__ unsigned cvtpk(float lo, float hi) { unsigned r; asm volatile("v_cvt_pk_bf16_f32 %0, %1, %2" : "=v"(r) : "v"(lo), "v"(hi)); return r; }
__device__ __forceinline__ void partialSM(f32x16& p0, f32x16& p1, float& m_reg, float& mn, float& alpha) {
  constexpr float C = SCALE * 1.4426950408889634f;
  float pmax = p0[0];
#pragma unroll
  for (int r = 1; r < 16; ++r) pmax = fmaxf(pmax, p0[r]);
#pragma unroll
  for (int r = 0; r < 16; ++r) pmax = fmaxf(pmax, p1[r]);
  { auto rr = __builtin_amdgcn_permlane32_swap(__float_as_uint(pmax), __float_as_uint(pmax), false, false);
    pmax = fmaxf(__uint_as_float(rr[0]), __uint_as_float(rr[1])); }
  if (__builtin_expect(__all(pmax - m_reg <= THR / SCALE), 1)) { mn = m_reg; alpha = 1.f; }
  else { mn = fmaxf(m_reg, pmax); alpha = __builtin_amdgcn_exp2f((m_reg - mn) * C); m_reg = mn; }
  float mnC = -mn * C;
#pragma unroll
  for (int r = 0; r < 16; ++r) p0[r] = fmaf(p0[r], C, mnC);
#pragma unroll
  for (int r = 0; r < 16; ++r) p1[r] = fmaf(p1[r], C, mnC);
#pragma unroll
  for (int r = 0; r < 16; ++r) p0[r] = __builtin_amdgcn_exp2f(p0[r]);
}
__device__ __forceinline__ void finishSM(f32x16& p0, f32x16& p1, float alpha, float& l_reg, bf16x8& pa0, bf16x8& pa1, bf16x8& pa2, bf16x8& pa3) {
#pragma unroll
  for (int r = 0; r < 16; ++r) p1[r] = __builtin_amdgcn_exp2f(p1[r]);
  (void)alpha; (void)l_reg;
#define ATT_PK4(P, BASE, OUT) do { unsigned a0 = cvtpk(P[BASE + 0], P[BASE + 1]), a1 = cvtpk(P[BASE + 2], P[BASE + 3]);   \
    unsigned b0 = cvtpk(P[BASE + 4], P[BASE + 5]), b1 = cvtpk(P[BASE + 6], P[BASE + 7]);                              \
    auto r0 = __builtin_amdgcn_permlane32_swap(a0, b0, false, false); auto r1 = __builtin_amdgcn_permlane32_swap(a1, b1, false, false); \
    u32x4 w = {r0[0], r1[0], r0[1], r1[1]}; OUT = *reinterpret_cast<bf16x8*>(&w); } while (0)
  ATT_PK4(p0, 0, pa0); ATT_PK4(p0, 8, pa1); ATT_PK4(p1, 0, pa2); ATT_PK4(p1, 8, pa3);
#undef ATT_PK4
}
__device__ __forceinline__ void qkt(f32x16& p0, f32x16& p1, const char* Ks, const bf16x8* qr, int r32, int hi) {
  p0 = f32x16{}; p1 = f32x16{};
#pragma unroll
  for (int d0 = 0; d0 < 6; ++d0) { const int cb = (d0 * 16 + hi * 8) * 2;
    bf16x8 b0 = *reinterpret_cast<const bf16x8*>(Ks + r32 * KROW + cb);
    bf16x8 b1 = *reinterpret_cast<const bf16x8*>(Ks + (32 + r32) * KROW + cb);
    p0 = __builtin_amdgcn_mfma_f32_32x32x16_bf16(b0, qr[d0], p0, 0, 0, 0);
    p1 = __builtin_amdgcn_mfma_f32_32x32x16_bf16(b1, qr[d0], p1, 0, 0, 0); }
}
__device__ __forceinline__ int v_st(int k, int c) { const int kk = (k & ~0xC) | ((k & 4) << 1) | ((k & 8) >> 1); return ((kk >> 3) * 2 + (c >> 5)) * 512 + ((kk & 7) * 32 + (c & 31)) * 2; }
__device__ __forceinline__ int v_rd_base(int lane) { return ((lane & 3) << 3) | (((lane >> 2) & 3) << 6) | (((lane >> 4) & 1) << 5) | (((lane >> 5) & 1) << 8); }
constexpr int v_rd_off(int d0, int ks, int half) { return d0 * 512 + ks * 2048 + half * 1024; }
template <int OFF> __device__ __forceinline__ s16x4 tr_read(int vb) {
  s16x4 r; asm volatile("ds_read_b64_tr_b16 %0, %1 offset:%2" : "=&v"(r) : "v"(vb), "i"(OFF) : "memory"); return r;
}
template <int D0> __device__ __forceinline__ void pv_one(f32x16& od, int vb, bf16x8 pa0, bf16x8 pa1, bf16x8 pa2, bf16x8 pa3) {
  const s16x4 l0 = tr_read<v_rd_off(D0, 0, 0)>(vb), h0 = tr_read<v_rd_off(D0, 0, 1)>(vb), l1 = tr_read<v_rd_off(D0, 1, 0)>(vb), h1 = tr_read<v_rd_off(D0, 1, 1)>(vb);
  const s16x4 l2 = tr_read<v_rd_off(D0, 2, 0)>(vb), h2 = tr_read<v_rd_off(D0, 2, 1)>(vb), l3 = tr_read<v_rd_off(D0, 3, 0)>(vb), h3 = tr_read<v_rd_off(D0, 3, 1)>(vb);
  asm volatile("s_waitcnt lgkmcnt(0)" ::: "memory"); ATT_SBAR();
#define ATT_PK(L, H) (bf16x8){L[0], L[1], L[2], L[3], H[0], H[1], H[2], H[3]}
  od = __builtin_amdgcn_mfma_f32_32x32x16_bf16(pa0, ATT_PK(l0, h0), od, 0, 0, 0);
  od = __builtin_amdgcn_mfma_f32_32x32x16_bf16(pa1, ATT_PK(l1, h1), od, 0, 0, 0);
  od = __builtin_amdgcn_mfma_f32_32x32x16_bf16(pa2, ATT_PK(l2, h2), od, 0, 0, 0);
  od = __builtin_amdgcn_mfma_f32_32x32x16_bf16(pa3, ATT_PK(l3, h3), od, 0, 0, 0);
#undef ATT_PK
}
__device__ __forceinline__ void pv_d0(f32x16* o, int vb, bf16x8 pa0, bf16x8 pa1, bf16x8 pa2, bf16x8 pa3) {
  pv_one<0>(o[0], vb, pa0, pa1, pa2, pa3); pv_one<1>(o[1], vb, pa0, pa1, pa2, pa3);
  const bf16x8 ones = {0x3F80, 0x3F80, 0x3F80, 0x3F80, 0x3F80, 0x3F80, 0x3F80, 0x3F80};
  o[2] = __builtin_amdgcn_mfma_f32_32x32x16_bf16(pa0, ones, o[2], 0, 0, 0);
  o[2] = __builtin_amdgcn_mfma_f32_32x32x16_bf16(pa1, ones, o[2], 0, 0, 0);
  o[2] = __builtin_amdgcn_mfma_f32_32x32x16_bf16(pa2, ones, o[2], 0, 0, 0);
  o[2] = __builtin_amdgcn_mfma_f32_32x32x16_bf16(pa3, ones, o[2], 0, 0, 0);
}
__device__ __forceinline__ void attn_body(const bf16_t* __restrict__ Qb, const bf16_t* __restrict__ Kh, const bf16_t* __restrict__ Vh, bf16_t* __restrict__ Ob, int seq, char* lds,
                                          const float* __restrict__ gq, const float* __restrict__ rope, int s0) {
  int tid = threadIdx.x; asm volatile("" : "+v"(tid));
  const int wid = tid >> 6, lane = tid & 63, r32 = lane & 31, hi = lane >> 5;
  char* V_lds = lds; char* K_lds = lds + 2 * SHM_V;
  float* wsl = (float*)(lds + 2 * SHM_V + 2 * SHM_K) + wid * 64; float* li_l = wsl; float* al_l = wsl + 32;
  float m_reg = -1e30f, l_reg = 0; f32x16 o[3] = {}; bf16x8 qr[6];
  const bf16_t* Qw = Qb + (long)(wid * 32 + r32) * LDQ + hi * 8;
  {
    uint4 raw[6]; float ss = 0.f;
#pragma unroll
    for (int d0 = 0; d0 < 6; ++d0) { raw[d0] = *reinterpret_cast<const uint4*>(Qw + d0 * 16); float t8[8]; unpack8(raw[d0], t8);
#pragma unroll
      for (int j = 0; j < 8; ++j) ss += t8[j] * t8[j]; }
    ss += __shfl_xor(ss, 32);
    const float rstd = rsqrtf(ss / 96.0f + EPS);
    const int spos = s0 + wid * 32 + r32;
#pragma unroll
    for (int d0 = 0; d0 < 6; ++d0) {
      float t8[8]; unpack8(raw[d0], t8);
      const float4 g0 = *(const float4*)(gq + d0 * 16 + hi * 8), g1 = *(const float4*)(gq + d0 * 16 + hi * 8 + 4);
      t8[0] *= rstd * g0.x; t8[1] *= rstd * g0.y; t8[2] *= rstd * g0.z; t8[3] *= rstd * g0.w; t8[4] *= rstd * g1.x; t8[5] *= rstd * g1.y; t8[6] *= rstd * g1.z; t8[7] *= rstd * g1.w;
      if (d0 >= 4) {
        const int pos = (d0 == 5) ? (spos & 63) : (spos >> 6);
#pragma unroll
        for (int j = 0; j < 8; ++j) {
          const float2 cs = *(const float2*)(rope + (pos * 8 + j) * 2);
          const float mine = t8[j], other = __shfl_xor(mine, 32);
          t8[j] = hi ? (mine * cs.x + other * cs.y) : (mine * cs.x - other * cs.y);
        }
      }
      const uint4 w = pack8(t8); qr[d0] = *reinterpret_cast<const bf16x8*>(&w);
      __builtin_amdgcn_sched_barrier(0);
    }
  }
  const bool k1on = tid < 256;
  const int kc0 = tid, kc1 = 512 + tid;
  const int kst0 = (kc0 / 12) * KROW + (kc0 % 12) * 16, kst1 = (kc1 / 12) * KROW + (kc1 % 12) * 16;
  const int vst0 = v_st(tid >> 3, (tid & 7) * 8);
  const int vb0 = (int)(uintptr_t)V_lds + v_rd_base(lane);
  struct { bf16x8 vs0, ks0, ks1; } sr_[2];
#define ATT_SLOAD(i, k0) do { sr_[i].vs0 = *reinterpret_cast<const bf16x8*>(Vh + (long)(k0) * 64 + tid * 8); \
    sr_[i].ks0 = *reinterpret_cast<const bf16x8*>(Kh + (long)(k0) * 96 + kc0 * 8); \
    if (k1on) sr_[i].ks1 = *reinterpret_cast<const bf16x8*>(Kh + (long)(k0) * 96 + kc1 * 8); } while (0)
#define ATT_SWRITE(b, i) do { *(bf16x8*)(V_lds + (b) * SHM_V + vst0) = sr_[i].vs0; \
    *(bf16x8*)(K_lds + (b) * SHM_K + kst0) = sr_[i].ks0; \
    if (k1on) *(bf16x8*)(K_lds + (b) * SHM_K + kst1) = sr_[i].ks1; } while (0)
#define ATT_SWAIT() asm volatile("s_waitcnt vmcnt(3)" ::: "memory")
#define ATT_RESC(a) do { if (__any((a) < 1.f)) { if (hi == 0) al_l[r32] = (a); asm volatile("s_waitcnt lgkmcnt(0)" ::: "memory"); \
    _Pragma("unroll") for (int d = 0; d < 3; ++d) _Pragma("unroll") for (int r = 0; r < 16; ++r) o[d][r] *= al_l[crow(r, hi)]; } } while (0)
  f32x16 pA0, pA1, pB0, pB1; float mnA, mnB, alA, alB; bf16x8 pa0, pa1, pa2, pa3; const int NT = seq / 64;
  constexpr int SE = 0, SO = 1;
  __syncthreads();
  ATT_SLOAD(SE, 0); asm volatile("s_waitcnt vmcnt(0)" ::: "memory"); ATT_SWRITE(0, SE); __syncthreads();
  qkt(pA0, pA1, K_lds, qr, r32, hi); partialSM(pA0, pA1, m_reg, mnA, alA);
  ATT_SLOAD(SO, 64); if (2 < NT) ATT_SLOAD(SE, 128);
  ATT_SWAIT(); ATT_SWRITE(1, SO); __syncthreads();
  for (int j = 1; j + 1 < NT; j += 2) {
    ATT_SBAR(); qkt(pB0, pB1, K_lds + SHM_K, qr, r32, hi);
    finishSM(pA0, pA1, alA, l_reg, pa0, pa1, pa2, pa3); ATT_SBAR();
    ATT_SLOAD(SO, (j + 2) * 64); ATT_SBAR();
    pv_d0(o, vb0, pa0, pa1, pa2, pa3); partialSM(pB0, pB1, m_reg, mnB, alB);
    __syncthreads(); ATT_SWAIT(); ATT_SWRITE(0, SE);
    ATT_RESC(alB); __syncthreads();
    ATT_SBAR(); qkt(pA0, pA1, K_lds, qr, r32, hi);
    finishSM(pB0, pB1, alB, l_reg, pa0, pa1, pa2, pa3); ATT_SBAR();
    if (j + 3 < NT) ATT_SLOAD(SE, (j + 3) * 64); ATT_SBAR();
    pv_d0(o, vb0 + SHM_V, pa0, pa1, pa2, pa3); partialSM(pA0, pA1, m_reg, mnA, alA);
    __syncthreads(); ATT_SWAIT(); ATT_SWRITE(1, SO);
    ATT_RESC(alA); __syncthreads();
  }
  ATT_SBAR(); qkt(pB0, pB1, K_lds + SHM_K, qr, r32, hi);
  finishSM(pA0, pA1, alA, l_reg, pa0, pa1, pa2, pa3); ATT_SBAR();
  pv_d0(o, vb0, pa0, pa1, pa2, pa3); partialSM(pB0, pB1, m_reg, mnB, alB);
  __syncthreads(); ATT_RESC(alB);
  finishSM(pB0, pB1, alB, l_reg, pa0, pa1, pa2, pa3); ATT_SBAR();
  pv_d0(o, vb0 + SHM_V, pa0, pa1, pa2, pa3);
  (void)li_l;
  float rli[16];
#pragma unroll
  for (int r = 0; r < 16; ++r) rli[r] = __builtin_amdgcn_rcpf(o[2][r]);
  bf16_t* Ow = Ob + (long)(wid * 32) * LDO;
#pragma unroll
  for (int r = 0; r < 16; ++r) { const int orow = crow(r, hi);
#pragma unroll
    for (int d0 = 0; d0 < 2; ++d0) Ow[(long)orow * LDO + d0 * 32 + r32] = f2bf(o[d0][r] * rli[r]); }
#undef ATT_SLOAD
#undef ATT_SWRITE
#undef ATT_SWAIT
#undef ATT_RESC
}
}

__device__ __forceinline__ void ph_attn_mfma(char* lds, const bf16_t* __restrict__ Q, const bf16_t* __restrict__ Kb, const bf16_t* __restrict__ Vb, bf16_t* __restrict__ mixin,
                                             const float* __restrict__ g_qk_q, const float* __restrict__ rope) {
    for (int unit = blockIdx.x; unit < NB * NH * 8; unit += gridDim.x) {
        const int xcd = unit & 7, slot = (unit >> 3) & 31, jj = unit >> 8;
        const int bh = xcd + 8 * ((slot >> 3) + 4 * jj), qblk = slot & 7, b = bh >> 3, h = bh & 7;
        att::attn_body(Q + ((size_t)(b * S + qblk * 256) * NH + h) * 96, Kb + (size_t)bh * SKV * 96, Vb + (size_t)bh * SKV * 64,
                       mixin + (size_t)(b * S + qblk * 256) * 1024 + 512 + h * 64, SKV, lds, g_qk_q, rope, qblk * 256);
    }
}


typedef float f32x2_t __attribute__((ext_vector_type(2)));


__device__ __forceinline__ void ph_cvt8n(const Ctx& cx, const float* __restrict__ pu, const float* __restrict__ pv, unsigned char* __restrict__ u4, unsigned char* __restrict__ v8,
                                         float* __restrict__ su, float* __restrict__ sv) {
    for (int r = cx.gwave; r < 2 * 16384; r += cx.nwave) {
        const bool isu = r < 16384; const int rr = isu ? r : r - 16384;
        const float* src = (isu ? pu : pv) + (size_t)rr * D + cx.lane * 16;
        float4 v[4]; float mx = 0.f;
#pragma unroll
        for (int i = 0; i < 4; ++i) { v[i] = *(const float4*)(src + i * 4); mx = fmaxf(mx, fmaxf(fmaxf(fabsf(v[i].x), fabsf(v[i].y)), fmaxf(fabsf(v[i].z), fabsf(v[i].w)))); }
        mx = wave_max(mx);
        if (isu) {
            const float s = mx > 0.f ? mx * 0.1f : 1.0f, inv = 1.0f / s;
            unsigned w0 = 0u, w1 = 0u;
            const float xs[16] = {v[0].x, v[0].y, v[0].z, v[0].w, v[1].x, v[1].y, v[1].z, v[1].w, v[2].x, v[2].y, v[2].z, v[2].w, v[3].x, v[3].y, v[3].z, v[3].w};
#pragma unroll
            for (int k = 0; k < 8; ++k) {
                int q0 = (int)rintf(xs[k] * inv), q1 = (int)rintf(xs[8 + k] * inv);
                q0 = q0 < -8 ? -8 : (q0 > 7 ? 7 : q0); q1 = q1 < -8 ? -8 : (q1 > 7 ? 7 : q1);
                w0 |= ((unsigned)q0 & 0xFu) << (4 * k); w1 |= ((unsigned)q1 & 0xFu) << (4 * k);
            }
            *(uint2*)(u4 + (size_t)(cx.lane >> 4) * (16384 * 128) + (size_t)rr * 128 + (cx.lane & 15) * 8) = make_uint2(w0, w1);
            if (cx.lane == 0) su[2 * rr] = s;
        } else {
            const float s = mx > 0.f ? mx * (0.85f / 6.0f) : 1.0f, inv = 1.0f / s;
            unsigned w0 = 0u, w1 = 0u;
            w0 = __builtin_amdgcn_cvt_scalef32_pk_fp4_f32(w0, v[0].x * inv, v[0].y * inv, 1.0f, 0); w0 = __builtin_amdgcn_cvt_scalef32_pk_fp4_f32(w0, v[0].z * inv, v[0].w * inv, 1.0f, 1);
            w0 = __builtin_amdgcn_cvt_scalef32_pk_fp4_f32(w0, v[1].x * inv, v[1].y * inv, 1.0f, 2); w0 = __builtin_amdgcn_cvt_scalef32_pk_fp4_f32(w0, v[1].z * inv, v[1].w * inv, 1.0f, 3);
            w1 = __builtin_amdgcn_cvt_scalef32_pk_fp4_f32(w1, v[2].x * inv, v[2].y * inv, 1.0f, 0); w1 = __builtin_amdgcn_cvt_scalef32_pk_fp4_f32(w1, v[2].z * inv, v[2].w * inv, 1.0f, 1);
            w1 = __builtin_amdgcn_cvt_scalef32_pk_fp4_f32(w1, v[3].x * inv, v[3].y * inv, 1.0f, 2); w1 = __builtin_amdgcn_cvt_scalef32_pk_fp4_f32(w1, v[3].z * inv, v[3].w * inv, 1.0f, 3);
            *(uint2*)(v8 + (size_t)(cx.lane >> 4) * (16384 * 128) + (size_t)rr * 128 + (cx.lane & 15) * 8) = make_uint2(w0, w1);
            if (cx.lane == 0) su[2 * rr + 1] = s;
        }
    }
}
#define LDI(ptr, idx) (*(const int*)((const char*)(ptr) + (unsigned)((idx) * 4)))
#define LDF(ptr, idx) (*(const float*)((const char*)(ptr) + (unsigned)((idx) * 4)))
#define LDU4(ptr, byteoff) (*(const uint4*)((const char*)(ptr) + (unsigned)(byteoff)))
__device__ __forceinline__ void ph_peer_u(const Ctx& cx, int rk, int nloc, int ti, int nteam, const unsigned* __restrict__ hqn, const float* __restrict__ hs, const int* __restrict__ eidx, const unsigned char* __restrict__ u4, float* __restrict__ pa) {
    const int lane = cx.lane, p = lane >> 3, q = lane & 7;
    for (int item = ti; item < 8; item += nteam) {
        const int c = item & 3, hf = item >> 2;
        const int ts = nloc * 16, tb = 2 * (rk * 8 + cx.wib) + hf;
        const int n = tb < T ? (T - 1 - tb) / ts + 1 : 0;
        if (n == 0) continue;
        const int tlast = tb + (n - 1) * ts;
        const unsigned hoff = (unsigned)((c * 32 + q * 4) * 4);
        const unsigned toff = (unsigned)(c * (16384 * 128) + q * 16);
        uint4 rows[16];
        const int t0 = tb, t1 = n > 1 ? tb + ts : tlast;
        int id0c = LDI(eidx, t0 * 128 + lane), id1c = LDI(eidx, t0 * 128 + 64 + lane);
        uint4 hhc = LDU4(hqn, t0 * 1024 + (int)hoff), hlc = LDU4(hqn, t0 * 1024 + 512 + (int)hoff); float shc = LDF(hs, t0);
        int id0n = LDI(eidx, t1 * 128 + lane), id1n = LDI(eidx, t1 * 128 + 64 + lane);
        uint4 hhn = LDU4(hqn, t1 * 1024 + (int)hoff), hln = LDU4(hqn, t1 * 1024 + 512 + (int)hoff); float shn = LDF(hs, t1);
#pragma unroll
        for (int r = 0; r < 16; ++r) { const int id = __shfl(r < 8 ? id0c : id1c, ((r * 8) & 63) + p); rows[r] = *(const uint4*)(u4 + ((unsigned)id * 128u + toff)); }
        for (int i = 0; i < n; ++i) {
            const int tcur = tb + i * ts;
            const int t2 = (i + 2 < n) ? tb + (i + 2) * ts : tlast;
            const int id0f = LDI(eidx, t2 * 128 + lane), id1f = LDI(eidx, t2 * 128 + 64 + lane);
            const uint4 hhf = LDU4(hqn, t2 * 1024 + (int)hoff), hlf4 = LDU4(hqn, t2 * 1024 + 512 + (int)hoff); const float shf = LDF(hs, t2);
            unsigned roffs[16];
#pragma unroll
            for (int r = 0; r < 16; ++r) roffs[r] = (unsigned)__shfl(r < 8 ? id0n : id1n, (r & 7) * 8 + p) * 128u + toff;
            float o0 = 0.f, o1 = 0.f;
#pragma unroll
            for (int r = 0; r < 16; ++r) {
                int ah = 0, al = 0;
                ah = __builtin_amdgcn_sdot8((int)rows[r].x, (int)hhc.x, ah, false); al = __builtin_amdgcn_sdot8((int)rows[r].x, (int)hlc.x, al, false);
                ah = __builtin_amdgcn_sdot8((int)rows[r].y, (int)hhc.y, ah, false); al = __builtin_amdgcn_sdot8((int)rows[r].y, (int)hlc.y, al, false);
                ah = __builtin_amdgcn_sdot8((int)rows[r].z, (int)hhc.z, ah, false); al = __builtin_amdgcn_sdot8((int)rows[r].z, (int)hlc.z, al, false);
                ah = __builtin_amdgcn_sdot8((int)rows[r].w, (int)hhc.w, ah, false); al = __builtin_amdgcn_sdot8((int)rows[r].w, (int)hlc.w, al, false);
                const float d = sum8_dpp((float)(ah * 16 + al));
                if (q == (r & 7)) { if (r < 8) o0 = d; else o1 = d; }
                rows[r] = *(const uint4*)(u4 + roffs[r]);
            }
            *(float*)((char*)(pa + (size_t)c * T * 128) + (unsigned)((tcur * 128 + q * 8 + p) * 4)) = o0 * shc;
            *(float*)((char*)(pa + (size_t)c * T * 128) + (unsigned)((tcur * 128 + 64 + q * 8 + p) * 4)) = o1 * shc;
            id0n = id0f; id1n = id1f; hhc = hhn; hlc = hln; shc = shn; hhn = hhf; hln = hlf4; shn = shf;
        }
    }
}
typedef float f32x2q_t __attribute__((ext_vector_type(2)));
struct R4In { int4 e0, e1; float4 p[4][2]; float4 g0, g1; };
__device__ __forceinline__ void r4_load(R4In& in, int it8, const float* __restrict__ pa, const int* __restrict__ eidx, const float* __restrict__ gates) {
    const int base = it8 * 8;
    in.e0 = *(const int4*)(eidx + base); in.e1 = *(const int4*)(eidx + base + 4);
#pragma unroll
    for (int x = 0; x < 4; ++x) { in.p[x][0] = *(const float4*)(pa + (size_t)x * T * 128 + base); in.p[x][1] = *(const float4*)(pa + (size_t)x * T * 128 + base + 4); }
    in.g0 = *(const float4*)(gates + base); in.g1 = *(const float4*)(gates + base + 4);
}
__device__ __forceinline__ void r4_scales(const R4In& in, const float* ssv, float2 (&sc)[8]) {
    const int ee[8] = {in.e0.x, in.e0.y, in.e0.z, in.e0.w, in.e1.x, in.e1.y, in.e1.z, in.e1.w};
#pragma unroll
    for (int k = 0; k < 8; ++k) sc[k] = *(const float2*)(ssv + 2 * ee[k]);
}
__device__ __forceinline__ void r4_finish(const R4In& in, const float2 (&sc)[8], int it8, unsigned* __restrict__ abuf, float* __restrict__ s0buf) {
    float aa[8] = {0.f, 0.f, 0.f, 0.f, 0.f, 0.f, 0.f, 0.f};
#pragma unroll
    for (int x = 0; x < 4; ++x) { aa[0] += in.p[x][0].x; aa[1] += in.p[x][0].y; aa[2] += in.p[x][0].z; aa[3] += in.p[x][0].w; aa[4] += in.p[x][1].x; aa[5] += in.p[x][1].y; aa[6] += in.p[x][1].z; aa[7] += in.p[x][1].w; }
    const float gg[8] = {in.g0.x, in.g0.y, in.g0.z, in.g0.w, in.g1.x, in.g1.y, in.g1.z, in.g1.w};
    float cc[8]; float mx = 0.f;
#pragma unroll
    for (int k = 0; k < 8; ++k) { const float a = aa[k] * sc[k].x; const float act = 0.5f * a * (1.0f + erff(a * 0.70710678118654752f)); cc[k] = gg[k] * act * sc[k].y; mx = fmaxf(mx, fabsf(cc[k])); }
    mx = fmaxf(mx, __shfl_xor(mx, 1)); mx = fmaxf(mx, __shfl_xor(mx, 2)); mx = fmaxf(mx, __shfl_xor(mx, 4)); mx = fmaxf(mx, __shfl_xor(mx, 8));
    const float s0 = mx > 0.f ? mx * (1.0f / 6.0f) : 1.0f, inv = 1.0f / s0;
    unsigned w[4] = {0u, 0u, 0u, 0u};
#define R4_PAIR(PR) do { float ra = cc[2 * (PR)] * inv, rb = cc[2 * (PR) + 1] * inv; \
        _Pragma("unroll") for (int tI = 0; tI < 4; ++tI) { \
            w[tI] = __builtin_amdgcn_cvt_scalef32_pk_fp4_f32(w[tI], ra, rb, 1.0f, PR); \
            const f32x2q_t d = __builtin_amdgcn_cvt_scalef32_pk_f32_fp4(w[tI], 1.0f, PR); \
            ra = (ra - d[0]) * 4.0f; rb = (rb - d[1]) * 4.0f; } } while (0)
    R4_PAIR(0); R4_PAIR(1); R4_PAIR(2); R4_PAIR(3);
#undef R4_PAIR
    const int t = it8 >> 4, j8 = it8 & 15;
#pragma unroll
    for (int tI = 0; tI < 4; ++tI) abuf[(t * 4 + tI) * 16 + j8] = w[tI];
    if (j8 == 0) s0buf[t] = s0;
}
__device__ __forceinline__ void ph_peer_r4(const Ctx& cx, char* lds, const float* __restrict__ pa, const int* __restrict__ eidx, const float* __restrict__ gates, const float* __restrict__ ssv_g,
                                           unsigned* __restrict__ abuf, float* __restrict__ s0buf) {
    __syncthreads();
    for (int e = cx.tid; e < 16384 * 2 / 4; e += NTHR) *(float4*)(lds + e * 16) = *(const float4*)(ssv_g + e * 4);
    __syncthreads();
    const float* ssv = (const float*)lds;
    for (int it8 = cx.gthr; it8 < T * 16; it8 += 2 * cx.nthr) {
        const int itB = it8 + cx.nthr; const bool hasB = itB < T * 16;
        R4In A, B; float2 sA[8], sB[8];
        r4_load(A, it8, pa, eidx, gates); r4_load(B, hasB ? itB : it8, pa, eidx, gates);
        r4_scales(A, ssv, sA); r4_scales(B, ssv, sB);
        r4_finish(A, sA, it8, abuf, s0buf);
        if (hasB) r4_finish(B, sB, itB, abuf, s0buf);
    }
    __syncthreads();
}
template <int OFF> __device__ __forceinline__ uint2 tr4_read(int vb) { uint2 r; asm volatile("ds_read_b64_tr_b4 %0, %1 offset:%2" : "=&v"(r) : "v"(vb), "i"(OFF) : "memory"); return r; }
typedef int i32x8v_t __attribute__((ext_vector_type(8)));
typedef float f32x4v_t __attribute__((ext_vector_type(4)));
__device__ __forceinline__ void ph_peer_v4(const Ctx& cx, char* lds, int rk, int nloc, int ti, int nteam, const int* __restrict__ eidx, const unsigned* __restrict__ abuf, const float* __restrict__ s0buf,
                                           const unsigned char* __restrict__ v4, const float* __restrict__ mod, const float* __restrict__ xin, const bf16_t* __restrict__ mixb, float* __restrict__ out) {
    const int lane = cx.lane, p = lane >> 3, q = lane & 7;
    const int m = lane & 15, g = lane >> 4, grp = m >> 2;
    char* wl = lds + cx.wib * 16384;
    float* ybuf = (float*)(lds + 131072 + cx.wib * 1024);
    const int rb = (int)(uintptr_t)wl + (32 * g + m) * 128, xs = m >> 1;
    const int wo_e = p * 128 + ((q ^ (p >> 1)) << 4), wo_o = p * 128 + ((q ^ (4 + (p >> 1))) << 4);
    const unsigned aoff = (unsigned)(((m & 3) * 16 + g * 4) * 4);
    for (int item = ti; item < 8; item += nteam) {
        const int c = item & 3, hf = item >> 2;
        const int ts = nloc * 16, tb = 2 * (rk * 8 + cx.wib) + hf;
        const int n = tb < T ? (T - 1 - tb) / ts + 1 : 0;
        if (n == 0) continue;
        const int tlast = tb + (n - 1) * ts;
        const unsigned toff = (unsigned)(c * (16384 * 128) + q * 16);
        const int col = c * 256 + lane * 4;
        uint4 rows[16];
        const int t0 = tb, t1 = n > 1 ? tb + ts : tlast;
        int id0c = LDI(eidx, t0 * 128 + lane), id1c = LDI(eidx, t0 * 128 + 64 + lane);
        uint4 Ac = LDU4(abuf, t0 * 256 + (int)aoff); float s0c = LDF(s0buf, t0);
        int id0n = LDI(eidx, t1 * 128 + lane), id1n = LDI(eidx, t1 * 128 + 64 + lane);
        uint4 An = LDU4(abuf, t1 * 256 + (int)aoff); float s0n = LDF(s0buf, t1);
#pragma unroll
        for (int r = 0; r < 16; ++r) { const int id = __shfl(r < 8 ? id0c : id1c, ((r * 8) & 63) + p); rows[r] = *(const uint4*)(v4 + ((unsigned)id * 128u + toff)); }
        for (int i = 0; i < n; ++i) {
            const int tcur = tb + i * ts;
            const int t2 = (i + 2 < n) ? tb + (i + 2) * ts : tlast;
            const int id0f = LDI(eidx, t2 * 128 + lane), id1f = LDI(eidx, t2 * 128 + 64 + lane);
            const uint4 Af = LDU4(abuf, t2 * 256 + (int)aoff); const float s0f = LDF(s0buf, t2);
            f32x4v_t gvc, g1c, xc; f32x2q_t mwf;
            { const unsigned og = (unsigned)(((tcur / S) * 6144 + 5 * D + col) * 4), o1 = (unsigned)(((tcur / S) * 6144 + 2 * D + col) * 4), ox = (unsigned)((tcur * D + col) * 4), om = (unsigned)((tcur * D + col) * 2);
              asm volatile("global_load_dwordx4 %0, %1, %2" : "=v"(gvc) : "v"(og), "s"(mod) : "memory");
              asm volatile("global_load_dwordx4 %0, %1, %2" : "=v"(g1c) : "v"(o1), "s"(mod) : "memory");
              asm volatile("global_load_dwordx4 %0, %1, %2" : "=v"(xc) : "v"(ox), "s"(xin) : "memory");
              asm volatile("global_load_dwordx2 %0, %1, %2" : "=v"(mwf) : "v"(om), "s"(mixb) : "memory"); }
            unsigned roffs[16];
#pragma unroll
            for (int r = 0; r < 16; ++r) roffs[r] = (unsigned)__shfl(r < 8 ? id0n : id1n, (r & 7) * 8 + p) * 128u + toff;
            __builtin_amdgcn_sched_barrier(0);
#pragma unroll
            for (int r = 0; r < 16; ++r) {
                { const uint4 w = rows[r]; *(uint4*)(wl + r * 1024 + ((r & 1) ? wo_o : wo_e)) = make_uint4(w.x, w.y, w.z, w.w); }
                __builtin_amdgcn_sched_barrier(0);
                rows[r] = *(const uint4*)(v4 + roffs[r]);
                __builtin_amdgcn_sched_barrier(0);
            }
#define V4_AG(G) (i32x8v_t{grp == (G) ? (int)Ac.x : 0, grp == (G) ? (int)Ac.y : 0, grp == (G) ? (int)Ac.z : 0, grp == (G) ? (int)Ac.w : 0, 0, 0, 0, 0})
            f32x4v_t acc[4];
#pragma unroll
            for (int k = 0; k < 4; ++k) acc[k] = f32x4v_t{0.f, 0.f, 0.f, 0.f};
#define V4_VQ(QD) (rb + (((QD) ^ xs) << 4))
#define V4_RD(NB, W) tr4_read<(W) * 2048 + ((NB) & 1) * 8>(V4_VQ((NB) >> 1))
#define V4_BATCH(N0) do { \
            const uint2 l0 = V4_RD(N0, 0), h0 = V4_RD(N0, 1), l1 = V4_RD(N0 + 1, 0), h1 = V4_RD(N0 + 1, 1), l2 = V4_RD(N0 + 2, 0), h2 = V4_RD(N0 + 2, 1), l3 = V4_RD(N0 + 3, 0), h3 = V4_RD(N0 + 3, 1); \
            asm volatile("s_waitcnt lgkmcnt(0)" ::: "memory"); __builtin_amdgcn_sched_barrier(0); \
            acc[(N0) >> 2] = __builtin_amdgcn_mfma_scale_f32_16x16x128_f8f6f4(V4_AG(0), (i32x8v_t{(int)l0.x, (int)l0.y, (int)h0.x, (int)h0.y, 0, 0, 0, 0}), acc[(N0) >> 2], 4, 4, 0, 0x7F7F7F7F, 0, 0x7F7F7F7F); \
            acc[(N0) >> 2] = __builtin_amdgcn_mfma_scale_f32_16x16x128_f8f6f4(V4_AG(1), (i32x8v_t{(int)l1.x, (int)l1.y, (int)h1.x, (int)h1.y, 0, 0, 0, 0}), acc[(N0) >> 2], 4, 4, 0, 0x7F7F7F7F, 0, 0x7F7F7F7F); \
            acc[(N0) >> 2] = __builtin_amdgcn_mfma_scale_f32_16x16x128_f8f6f4(V4_AG(2), (i32x8v_t{(int)l2.x, (int)l2.y, (int)h2.x, (int)h2.y, 0, 0, 0, 0}), acc[(N0) >> 2], 4, 4, 0, 0x7F7F7F7F, 0, 0x7F7F7F7F); \
            acc[(N0) >> 2] = __builtin_amdgcn_mfma_scale_f32_16x16x128_f8f6f4(V4_AG(3), (i32x8v_t{(int)l3.x, (int)l3.y, (int)h3.x, (int)h3.y, 0, 0, 0, 0}), acc[(N0) >> 2], 4, 4, 0, 0x7F7F7F7F, 0, 0x7F7F7F7F); } while (0)
            V4_BATCH(0); V4_BATCH(4); V4_BATCH(8); V4_BATCH(12);
#undef V4_BATCH
#undef V4_RD
#undef V4_VQ
#undef V4_AG
#pragma unroll
            for (int k = 0; k < 4; ++k) ybuf[64 * k + lane] = s0c * (acc[k][0] + 0.25f * acc[k][1] + 0.0625f * acc[k][2] + 0.015625f * acc[k][3]);
            const float4 yv = *(const float4*)(ybuf + 4 * lane);
            asm volatile("s_waitcnt vmcnt(16)" : "+v"(gvc), "+v"(g1c), "+v"(xc), "+v"(mwf) :: "memory");
            const unsigned mw0 = __float_as_uint(mwf[0]), mw1 = __float_as_uint(mwf[1]);
            float4 ov = make_float4(xc[0], xc[1], xc[2], xc[3]);
            ov.x += g1c[0] * __uint_as_float(mw0 << 16); ov.y += g1c[1] * __uint_as_float(mw0 & 0xffff0000u); ov.z += g1c[2] * __uint_as_float(mw1 << 16); ov.w += g1c[3] * __uint_as_float(mw1 & 0xffff0000u);
            ov.x += gvc[0] * yv.x; ov.y += gvc[1] * yv.y; ov.z += gvc[2] * yv.z; ov.w += gvc[3] * yv.w;
            *(float4*)((char*)out + (unsigned)((tcur * D + col) * 4)) = ov;
            id0n = id0f; id1n = id1f; Ac = An; An = Af; s0c = s0n; s0n = s0f;
        }
    }
}

namespace tk {
using bf16x8 = __attribute__((ext_vector_type(8))) short;
using f32x16 = __attribute__((ext_vector_type(16))) float;
constexpr int SKROW = 272;
constexpr int SK_BYTES = 2 * 128 * SKROW;
constexpr int IDX_OFF = SK_BYTES;
__device__ __forceinline__ void ce_desc(float& a, float& b) {
    float hi, lo;
    asm("v_max_f32 %0, %1, %2" : "=v"(hi) : "v"(a), "v"(b));
    asm("v_min_f32 %0, %1, %2" : "=v"(lo) : "v"(a), "v"(b));
    a = hi; b = lo;
}
__device__ __forceinline__ float fmax_raw(float a, float b) { float r; asm("v_max_f32 %0, %1, %2" : "=v"(r) : "v"(a), "v"(b)); return r; }
__device__ __forceinline__ void sort16(float (&k)[16]) {
#define CE(i, j) ce_desc(k[i], k[j])
    CE(0,1); CE(2,3); CE(0,2); CE(1,3); CE(1,2); CE(4,5); CE(6,7); CE(4,6); CE(5,7); CE(5,6); CE(0,4); CE(2,6); CE(2,4); CE(1,5); CE(3,7); CE(3,5); CE(1,2); CE(3,4); CE(5,6); CE(8,9); CE(10,11); CE(8,10); CE(9,11); CE(9,10); CE(12,13); CE(14,15); CE(12,14); CE(13,15); CE(13,14); CE(8,12); CE(10,14); CE(10,12); CE(9,13); CE(11,15); CE(11,13); CE(9,10); CE(11,12); CE(13,14); CE(0,8); CE(4,12); CE(4,8); CE(2,10); CE(6,14); CE(6,10); CE(2,4); CE(6,8); CE(10,12); CE(1,9); CE(5,13); CE(5,9); CE(3,11); CE(7,15); CE(7,11); CE(3,5); CE(7,9); CE(11,13); CE(1,2); CE(3,4); CE(5,6); CE(7,8); CE(9,10); CE(11,12); CE(13,14);
#undef CE
}
__device__ __forceinline__ void bmerge16(float (&k)[16]) {
#pragma unroll
    for (int j = 8; j > 0; j >>= 1)
#pragma unroll
        for (int i = 0; i < 16; ++i) { const int l = i ^ j; if (l > i) ce_desc(k[i], k[l]); }
}
__device__ __forceinline__ void merge_top16(float (&a)[16], const float (&b)[16]) {
#pragma unroll
    for (int i = 0; i < 16; ++i) a[i] = fmax_raw(a[i], b[15 - i]);
    bmerge16(a);
}
__device__ __forceinline__ void half_top16(const char* sk_lds, const bf16_t* __restrict__ qrow, int p, int r32, int hi, float (&top)[16]) {
    bf16x8 qf[8];
#pragma unroll
    for (int ks = 0; ks < 8; ++ks) qf[ks] = *reinterpret_cast<const bf16x8*>(qrow + p * 128 + ks * 16 + hi * 8);
    float grp[4][16];
#pragma unroll
    for (int blk = 0; blk < 4; ++blk) {
        f32x16 acc = {};
        const char* arow = sk_lds + (p * 128 + blk * 32 + r32) * SKROW + hi * 16;
#pragma unroll
        for (int ks = 0; ks < 8; ++ks) { const bf16x8 af = *reinterpret_cast<const bf16x8*>(arow + ks * 32); acc = __builtin_amdgcn_mfma_f32_32x32x16_bf16(af, qf[ks], acc, 0, 0, 0); }
#pragma unroll
        for (int r = 0; r < 16; ++r) { const int base = blk * 32 + (r & 3) + 8 * (r >> 2); grp[blk][r] = __uint_as_float((__float_as_uint(acc[r]) & ~0x7Fu) | (unsigned)(127 - base)); }
        sort16(grp[blk]);
        __builtin_amdgcn_sched_barrier(0);
    }
    merge_top16(grp[0], grp[1]); merge_top16(grp[2], grp[3]); merge_top16(grp[0], grp[2]);
    const unsigned hx = (unsigned)hi << 2;
    float mine[16], other[16];
#pragma unroll
    for (int i = 0; i < 16; ++i) { mine[i] = __uint_as_float(__float_as_uint(grp[0][i]) ^ hx); other[i] = __shfl_xor(mine[i], 32); }
    merge_top16(mine, other);
#pragma unroll
    for (int i = 0; i < 16; ++i) top[i] = mine[i];
}
__device__ __forceinline__ float cand(const float (&v1)[16], const float (&v2)[16], int a, int b) {
    return __uint_as_float((__float_as_uint(v1[a] + v2[b]) & ~0xFFu) | (unsigned)(255 - (a * 16 + b)));
}
__device__ __forceinline__ void ph_topk_mfma(const Ctx& cx, char* lds, const bf16_t* __restrict__ qp, const float* __restrict__ sub_keys, int* __restrict__ eidx, float* __restrict__ gates) {
    __syncthreads();
    for (int e = cx.tid; e < 2 * 128 * 16; e += NTHR) {
        const int row = e >> 4, c8 = (e & 15) * 8;
        const float4 f0 = *(const float4*)(sub_keys + (size_t)row * 128 + c8), f1 = *(const float4*)(sub_keys + (size_t)row * 128 + c8 + 4);
        uint4 w; w.x = (unsigned)f2bf(f0.x) | ((unsigned)f2bf(f0.y) << 16); w.y = (unsigned)f2bf(f0.z) | ((unsigned)f2bf(f0.w) << 16);
        w.z = (unsigned)f2bf(f1.x) | ((unsigned)f2bf(f1.y) << 16); w.w = (unsigned)f2bf(f1.z) | ((unsigned)f2bf(f1.w) << 16);
        *(uint4*)(lds + row * SKROW + c8 * 2) = w;
    }
    __syncthreads();
    const int r32 = cx.lane & 31, hi = cx.lane >> 5;
    unsigned char* itab = (unsigned char*)(lds + IDX_OFF + cx.tid * 32);
    for (int unit = cx.gwave; unit < (T / 32) * 8; unit += cx.nwave) {
        const int tb = unit >> 3, h = unit & 7, t = tb * 32 + r32;
        const bf16_t* qrow = qp + (size_t)t * 2048 + h * 256;
        float k1[16], k2[16];
        half_top16(lds, qrow, 0, r32, hi, k1);
        __builtin_amdgcn_sched_barrier(0);
        half_top16(lds, qrow, 1, r32, hi, k2);
        __builtin_amdgcn_sched_barrier(0);
        float v1[16], v2[16];
        {
            unsigned nb[8];
#pragma unroll
            for (int i = 0; i < 8; ++i) nb[i] = 0u;
#pragma unroll
            for (int i = 0; i < 16; ++i) {
                const unsigned u1 = __float_as_uint(k1[i]), u2 = __float_as_uint(k2[i]);
                v1[i] = __uint_as_float(u1 & ~0x7Fu); v2[i] = __uint_as_float(u2 & ~0x7Fu);
                nb[i >> 2] |= (127u - (u1 & 0x7Fu)) << (8 * (i & 3)); nb[4 + (i >> 2)] |= (127u - (u2 & 0x7Fu)) << (8 * (i & 3));
            }
            *(uint4*)(itab) = make_uint4(nb[0], nb[1], nb[2], nb[3]); *(uint4*)(itab + 16) = make_uint4(nb[4], nb[5], nb[6], nb[7]);
        }
        float A[16], Bq[16], Cq[16], Dq[16];
#pragma unroll
        for (int b = 0; b < 16; ++b) A[b] = cand(v1, v2, 0, b);
#pragma unroll
        for (int b = 0; b < 8; ++b) Bq[b] = cand(v1, v2, 1, b);
#pragma unroll
        for (int i = 0; i < 8; ++i) Bq[8 + i] = cand(v1, v2, 15 - i, 0);
        bmerge16(Bq);
        __builtin_amdgcn_sched_barrier(0);
        merge_top16(A, Bq);
        __builtin_amdgcn_sched_barrier(0);
        Cq[0] = cand(v1, v2, 2, 0); Cq[1] = cand(v1, v2, 2, 1); Cq[2] = cand(v1, v2, 2, 2); Cq[3] = cand(v1, v2, 2, 3); Cq[4] = cand(v1, v2, 2, 4);
        Cq[5] = cand(v1, v2, 3, 0); Cq[6] = cand(v1, v2, 3, 1); Cq[7] = cand(v1, v2, 3, 2); Cq[8] = cand(v1, v2, 3, 3);
        Cq[9] = cand(v1, v2, 4, 0); Cq[10] = cand(v1, v2, 4, 1); Cq[11] = cand(v1, v2, 4, 2);
        Cq[12] = cand(v1, v2, 5, 0); Cq[13] = cand(v1, v2, 5, 1); Cq[14] = cand(v1, v2, 6, 0); Cq[15] = cand(v1, v2, 6, 1);
        sort16(Cq);
        __builtin_amdgcn_sched_barrier(0);
        Dq[0] = cand(v1, v2, 7, 0); Dq[1] = cand(v1, v2, 7, 1);
        ce_desc(Dq[0], Dq[1]);
#pragma unroll
        for (int i = 2; i < 16; ++i) Dq[i] = -INFINITY;
        merge_top16(Cq, Dq);
        __builtin_amdgcn_sched_barrier(0);
        merge_top16(A, Cq);
        int eo[16]; float tv[16]; float sum = 0.f;
#pragma unroll
        for (int i = 0; i < 16; ++i) {
            const unsigned u = __float_as_uint(A[i]); const unsigned pos = 255u - (u & 0xFFu);
            eo[i] = (int)itab[pos >> 4] * 128 + (int)itab[16 + (pos & 15)];
            tv[i] = __uint_as_float(u & ~0xFFu);
        }
        const float tmx = tv[0];
#pragma unroll
        for (int i = 0; i < 16; ++i) { tv[i] = __expf(tv[i] - tmx); sum += tv[i]; }
        const float inv = 1.0f / sum;
        if (hi == 0) {
            int* ep = eidx + (size_t)t * 128 + h * 16;
#pragma unroll
            for (int i = 0; i < 4; ++i) *(int4*)(ep + i * 4) = make_int4(eo[i * 4], eo[i * 4 + 1], eo[i * 4 + 2], eo[i * 4 + 3]);
        } else {
            float* gp = gates + (size_t)t * 128 + h * 16;
#pragma unroll
            for (int i = 0; i < 4; ++i) *(float4*)(gp + i * 4) = make_float4(tv[i * 4] * inv, tv[i * 4 + 1] * inv, tv[i * 4 + 2] * inv, tv[i * 4 + 3] * inv);
        }
    }
}
}


__device__ __forceinline__ void ph_fold(const Ctx& cx, char* lds, const float* __restrict__ pool_w, const float* __restrict__ pool_scale, const float* __restrict__ w_out, bf16_t* __restrict__ wt_out) {
    float (*P)[132] = (float (*)[132])lds;
    float (*Wn)[16] = (float (*)[16])(lds + 128 * 132 * 4);
    const int tid = cx.tid;
    for (int item = blockIdx.x; item < 4 * 64; item += gridDim.x) {
        const int g = item >> 6, nt = item & 63;
        __syncthreads();
#pragma unroll
        for (int i = 0; i < 8; ++i) {
            const int e = tid + 512 * i, c = e >> 5, j4 = (e & 31) * 4;
            const float4 pw = *(const float4*)(pool_w + ((size_t)g * 128 + c) * 128 + j4);
            const float4 ps = *(const float4*)(pool_scale + g * 128 + j4);
            *(float4*)&P[c][j4] = make_float4(pw.x * ps.x, pw.y * ps.y, pw.z * ps.z, pw.w * ps.w);
        }
        { const int j = tid >> 2, n4 = (tid & 3) * 4;
          *(float4*)&Wn[j][n4] = *(const float4*)(w_out + (size_t)(g * 128 + j) * 1024 + nt * 16 + n4); }
        __syncthreads();
        const int c4 = tid >> 4, n = tid & 15;
        float a0 = 0.f, a1 = 0.f, a2 = 0.f, a3 = 0.f;
#pragma unroll 8
        for (int j = 0; j < 128; j += 4) {
            const float4 p0 = *(const float4*)&P[4 * c4][j], p1 = *(const float4*)&P[4 * c4 + 1][j], p2 = *(const float4*)&P[4 * c4 + 2][j], p3 = *(const float4*)&P[4 * c4 + 3][j];
            const float w0 = Wn[j][n], w1 = Wn[j + 1][n], w2 = Wn[j + 2][n], w3 = Wn[j + 3][n];
            a0 = fmaf(p0.x, w0, a0); a0 = fmaf(p0.y, w1, a0); a0 = fmaf(p0.z, w2, a0); a0 = fmaf(p0.w, w3, a0);
            a1 = fmaf(p1.x, w0, a1); a1 = fmaf(p1.y, w1, a1); a1 = fmaf(p1.z, w2, a1); a1 = fmaf(p1.w, w3, a1);
            a2 = fmaf(p2.x, w0, a2); a2 = fmaf(p2.y, w1, a2); a2 = fmaf(p2.z, w2, a2); a2 = fmaf(p2.w, w3, a2);
            a3 = fmaf(p3.x, w0, a3); a3 = fmaf(p3.y, w1, a3); a3 = fmaf(p3.z, w2, a3); a3 = fmaf(p3.w, w3, a3);
        }
        *(uint2*)(wt_out + (size_t)(nt * 16 + n) * 1024 + g * 128 + 4 * c4) = make_uint2((unsigned)f2bf(a0) | ((unsigned)f2bf(a1) << 16), (unsigned)f2bf(a2) | ((unsigned)f2bf(a3) << 16));
    }
    __syncthreads();
}
__device__ __forceinline__ void ph_pm8(const Ctx& cx, const bf16_t* __restrict__ proj, bf16_t* __restrict__ mixin) {
    const int lane = cx.lane, W = 2 << (lane >> 4), hw = W >> 1;
    for (int run = cx.gwave; run < T / 16; run += cx.nwave) {
        const int t0 = run * 16, s0 = t0 & (S - 1);
        const bf16_t* base = proj + (size_t)(t0 - s0) * PLD + lane * 8;
        float sum[8];
#pragma unroll
        for (int i = 0; i < 8; ++i) sum[i] = 0.f;
        {   uint4 v[16];
#pragma unroll
            for (int k = 0; k < 16; ++k) { int j = s0 - hw + k; j = j < 0 ? 0 : (j > S - 1 ? S - 1 : j); v[k] = *(const uint4*)(base + (size_t)j * PLD); }
#pragma unroll
            for (int k = 0; k < 16; ++k) { const int j = s0 - hw + k; const float m = (k < W && j >= 0 && j < S) ? 1.0f : 0.0f; float f[8]; unpack8(v[k], f);
#pragma unroll
                for (int i = 0; i < 8; ++i) sum[i] = fmaf(m, f[i], sum[i]); }
        }
#pragma unroll
        for (int q4 = 0; q4 < 4; ++q4) {
            uint4 cv[4], av[4], sv[4];
#pragma unroll
            for (int u = 0; u < 4; ++u) { const int s = s0 + q4 * 4 + u; int ja = s + hw, js = s - hw; ja = ja > S - 1 ? S - 1 : ja; js = js < 0 ? 0 : js;
                cv[u] = *(const uint4*)(base + (size_t)s * PLD); av[u] = *(const uint4*)(base + (size_t)ja * PLD); sv[u] = *(const uint4*)(base + (size_t)js * PLD); }
#pragma unroll
            for (int u = 0; u < 4; ++u) { const int s = s0 + q4 * 4 + u;
                int lo = s - hw; if (lo < 0) lo = 0;
                int hi = s + hw; if (hi > S) hi = S;
                const float inv = 1.0f / (float)(hi - lo);
                float c[8], o[8]; unpack8(cv[u], c);
#pragma unroll
                for (int i = 0; i < 8; ++i) o[i] = sum[i] * inv - c[i];
                *(uint4*)(mixin + (size_t)(t0 + q4 * 4 + u) * 1024 + lane * 8) = pack8(o);
                const float ma = (s + hw < S) ? 1.0f : 0.0f, ms = (s - hw >= 0) ? 1.0f : 0.0f;
                float fa[8], fs[8]; unpack8(av[u], fa); unpack8(sv[u], fs);
#pragma unroll
                for (int i = 0; i < 8; ++i) sum[i] = fmaf(ma, fa[i], fmaf(-ms, fs[i], sum[i]));
            }
        }
    }
}
__device__ __forceinline__ void ph_rms2(const Ctx& cx, const bf16_t* __restrict__ proj, const float* __restrict__ g_q, const float* __restrict__ g_kv, bf16_t* __restrict__ cqn, bf16_t* __restrict__ ckvn) {
    const int lane = cx.lane;
    float gq[8], gk[8];
#pragma unroll
    for (int i = 0; i < 8; ++i) { gq[i] = lane < 48 ? g_q[lane * 8 + i] : 0.f; gk[i] = lane < 32 ? g_kv[lane * 8 + i] : 0.f; }
    for (int rb = cx.gwave * 8; rb < TA; rb += cx.nwave * 8) {
        uint4 vq[8], vk[8];
#pragma unroll
        for (int u = 0; u < 8; ++u) {
            const int r = rb + u;
            vq[u] = make_uint4(0, 0, 0, 0); vk[u] = make_uint4(0, 0, 0, 0);
            if (r < T && lane < 48) vq[u] = *(const uint4*)(proj + (size_t)r * PLD + O_CQ + lane * 8);
            if (lane < 32) vk[u] = *(const uint4*)(proj + (size_t)r * PLD + O_CKV + lane * 8);
        }
#pragma unroll
        for (int u = 0; u < 8; ++u) {
            const int r = rb + u; const bool hasq = r < T;
            float fq[8], fk[8];
            unpack8(vq[u], fq); unpack8(vk[u], fk);
            float sq = 0.f, sk = 0.f;
#pragma unroll
            for (int i = 0; i < 8; ++i) { sq += fq[i] * fq[i]; sk += fk[i] * fk[i]; }
            sq = wave_sum(sq); sk = wave_sum(sk);
            const float rq = rsqrtf(sq / (float)QL + EPS), rk = rsqrtf(sk / (float)KVL + EPS);
#pragma unroll
            for (int i = 0; i < 8; ++i) { fq[i] = fq[i] * rq * gq[i]; fk[i] = fk[i] * rk * gk[i]; }
            if (hasq && lane < 48) *(uint4*)(cqn + (size_t)r * QL + lane * 8) = pack8(fq);
            if (lane < 32) *(uint4*)(ckvn + (size_t)r * KVL + lane * 8) = pack8(fk);
        }
    }
}
__device__ __forceinline__ float sum8(float v) { return sum8_dpp(v); }
__device__ __forceinline__ void ph_kfin(const Ctx& cx, const bf16_t* __restrict__ proj, const float* __restrict__ g_qk_k, const float* __restrict__ rope, bf16_t* __restrict__ Kb) {
    const int lane = cx.lane, kq = lane >> 3, p = lane & 7;
    float gk[8], gr[8];
#pragma unroll
    for (int j = 0; j < 8; ++j) { gk[j] = g_qk_k[8 * p + j]; gr[j] = g_qk_k[64 + 8 * (p & 3) + j]; }
    constexpr int NIT = NB * NH * (SKV / 8);
    for (int it0 = cx.gwave; it0 < NIT; it0 += 4 * cx.nwave) {
        bf16_t* rec[4]; uint4 raw[4], rr[4]; int keyv[4]; bool on[4];
#pragma unroll
        for (int u = 0; u < 4; ++u) {
            const int it = it0 + u * cx.nwave; on[u] = it < NIT; const int itc = on[u] ? it : it0;
            const int bh = itc / (SKV / 8), key = (itc - bh * (SKV / 8)) * 8 + kq, b = bh >> 3;
            keyv[u] = key; rec[u] = Kb + ((size_t)bh * SKV + key) * 96;
            const int trow = key < S ? b * S + key : T + b * CTXL + (key - S);
            raw[u] = *(const uint4*)(rec[u] + 8 * p);
            rr[u] = p < 4 ? *(const uint4*)(proj + (size_t)trow * PLD + O_KR + 8 * p) : make_uint4(0u, 0u, 0u, 0u);
        }
#pragma unroll
        for (int u = 0; u < 4; ++u) {
            const int key = keyv[u]; const bool lat = key < S;
            float x[8], r[8]; unpack8(raw[u], x); unpack8(rr[u], r);
            float ss = 0.f;
#pragma unroll
            for (int j = 0; j < 8; ++j) ss += x[j] * x[j] + r[j] * r[j];
            ss = sum8(ss);
            const float rstd = rsqrtf(ss / 96.0f + EPS);
#pragma unroll
            for (int j = 0; j < 8; ++j) { x[j] *= rstd * gk[j]; r[j] *= rstd * gr[j]; }
            if (lat) {
                const int pos = (p & 2) ? (key & 63) : (key >> 6);
#pragma unroll
                for (int j = 0; j < 8; ++j) {
                    const float2 cs = *(const float2*)(rope + (pos * 8 + j) * 2);
                    const float mine = r[j], other = __shfl_xor(mine, 1);
                    r[j] = (p & 1) ? (mine * cs.x + other * cs.y) : (mine * cs.x - other * cs.y);
                }
            }
            if (on[u]) { *(uint4*)(rec[u] + 8 * p) = pack8(x); if (p < 4) *(uint4*)(rec[u] + 64 + 8 * p) = pack8(r); }
        }
    }
}

#define XB_LAS __attribute__((address_space(3)))
#define XB_TMO      128
#define XB_XCNT(j)  (256  + 64 * (j))
#define XB_XSUB(j)  (1280 + 64 * (j))
#define XB_XGEN(j)  (2304 + 64 * (j))
#define XB_TOP      3328
#define XB_TOPGEN   3392
#define XCD_BAR_WORDS 3456
#define XB_SPIN_CAP (1u << 18)
__device__ __forceinline__ unsigned xb_ld(unsigned* p)              { return __hip_atomic_load(p, __ATOMIC_RELAXED, __HIP_MEMORY_SCOPE_AGENT); }
__device__ __forceinline__ unsigned xb_add(unsigned* p, unsigned v) { return __hip_atomic_fetch_add(p, v, __ATOMIC_RELAXED, __HIP_MEMORY_SCOPE_AGENT); }
__device__ __forceinline__ unsigned xb_xcc_id() { return (unsigned)__builtin_amdgcn_s_getreg((3 << 11) | 20) & 0xFu; }
#define XB_SPIN(cond, bar) do { unsigned _sp = 0; while (cond) { __builtin_amdgcn_s_sleep(1); \
    if ((++_sp & 255u) == 0u) { if (xb_ld(&(bar)[XB_TMO])) break; if (_sp > XB_SPIN_CAP) { atomicAdd(&(bar)[XB_TMO], 1u); break; } } } } while (0)
struct XcdBarrier { unsigned* bar; unsigned x; volatile XB_LAS unsigned* st; };
__device__ __forceinline__ XcdBarrier xcd_barrier_post(unsigned* bar, volatile XB_LAS unsigned* st) {
    XcdBarrier b; b.bar = bar; b.x = xb_xcc_id(); b.st = st;
    if (threadIdx.x == 0) (void)xb_add(&bar[XB_XCNT(b.x)], 1u);
    return b;
}
__device__ __forceinline__ void xcd_barrier_complete(unsigned* bar, unsigned x, unsigned& nloc, unsigned& nx) {
    const unsigned G = gridDim.x * gridDim.y * gridDim.z;
    unsigned sum, cnt, mine, sp = 0u;
    for (;;) {
        sum = 0u; cnt = 0u; mine = 0u;
#pragma unroll
        for (unsigned j = 0; j < 16; ++j) { const unsigned c = xb_ld(&bar[XB_XCNT(j)]); sum += c; cnt += (c > 0u) ? 1u : 0u; mine = (j == x) ? c : mine; }
        if (sum == G) break;
        __builtin_amdgcn_s_sleep(1);
        if ((++sp & 255u) == 0u) { if (xb_ld(&bar[XB_TMO])) break; if (sp > XB_SPIN_CAP) { atomicAdd(&bar[XB_TMO], 1u); break; } }
    }
    nloc = mine > 0u ? mine : 1u; nx = cnt > 0u ? cnt : 1u;
}
__device__ __forceinline__ void xcd_barrier(const XcdBarrier& b) {
    asm volatile("s_waitcnt vmcnt(0)" ::: "memory");
    __syncthreads();
    if (threadIdx.x == 0) {
        unsigned* bar = b.bar;
        __builtin_amdgcn_s_waitcnt(0);
        unsigned nloc = b.st[0], nx = b.st[1];
        if (nloc == 0u) { xcd_barrier_complete(bar, b.x, nloc, nx); b.st[0] = nloc; b.st[1] = nx; }
        const unsigned old = xb_add(&bar[XB_XSUB(b.x)], 1u);
        const unsigned gen = old / nloc;
        if (old + 1u == (gen + 1u) * nloc) {
            __builtin_amdgcn_fence(__ATOMIC_RELEASE, "agent");
            asm volatile("s_waitcnt vmcnt(0)" ::: "memory");
            const unsigned og = xb_add(&bar[XB_TOP], 1u);
            const unsigned tg = og / nx;
            if (og + 1u == (tg + 1u) * nx) xb_add(&bar[XB_TOPGEN], 1u);
            else XB_SPIN(xb_ld(&bar[XB_TOPGEN]) == tg, bar);
            __builtin_amdgcn_fence(__ATOMIC_ACQUIRE, "agent");
            xb_add(&bar[XB_XGEN(b.x)], 1u);
            asm volatile("s_waitcnt vmcnt(0)" ::: "memory");
        } else {
            XB_SPIN(xb_ld(&bar[XB_XGEN(b.x)]) == gen, bar);
            __builtin_amdgcn_fence(__ATOMIC_ACQUIRE, "agent");
            asm volatile("s_waitcnt vmcnt(0)" ::: "memory");
        }
    }
    __syncthreads();
}

__device__ __forceinline__ void ph_mod2(const Ctx& cx, char* lds, const float* __restrict__ c, const float* __restrict__ c_ctx, const float* __restrict__ w_ada,
                                        const float* __restrict__ b_ada, float* __restrict__ mod, float* __restrict__ rope) {
    float* sl = (float*)lds;
    float* red = (float*)(lds + 17 * 1024 * 4);
    const int tid = cx.tid;
    if (blockIdx.x == 0 && tid < 512) { const int pos = tid >> 3, i = tid & 7; const float inv = 1.0f / powf(10000.0f, (float)i / 8.0f); const float a = (float)pos * inv; rope[2 * tid] = cosf(a); rope[2 * tid + 1] = sinf(a); }
    __syncthreads();
    {   float xv[34];
#pragma unroll
        for (int i = 0; i < 34; ++i) { const int e = tid + NTHR * i; xv[i] = (e < 16 * 1024) ? c[e] : c_ctx[e - 16 * 1024]; }
#pragma unroll
        for (int i = 0; i < 34; ++i) sl[tid + NTHR * i] = xv[i] / (1.0f + expf(-xv[i])); }
    __syncthreads();
    const int cg = tid % 6, ks = tid / 6;
    for (int cb = blockIdx.x; cb < 256; cb += gridDim.x) {
        float acc[17][4];
#pragma unroll
        for (int b = 0; b < 17; ++b) { acc[b][0] = 0.f; acc[b][1] = 0.f; acc[b][2] = 0.f; acc[b][3] = 0.f; }
        if (tid < 510) {
            float4 w[13];
#pragma unroll
            for (int i = 0; i < 13; ++i) { const int k = ks + 85 * i; w[i] = (k < 1024) ? *(const float4*)(w_ada + (size_t)k * 6144 + cb * 24 + cg * 4) : make_float4(0.f, 0.f, 0.f, 0.f); }
#pragma unroll
            for (int i = 0; i < 13; ++i) {
                const int k = (ks + 85 * i) & 1023;
#pragma unroll
                for (int b = 0; b < 17; ++b) { const float s = sl[b * 1024 + k]; acc[b][0] = fmaf(s, w[i].x, acc[b][0]); acc[b][1] = fmaf(s, w[i].y, acc[b][1]); acc[b][2] = fmaf(s, w[i].z, acc[b][2]); acc[b][3] = fmaf(s, w[i].w, acc[b][3]); }
            }
        }
#pragma unroll
        for (int rd = 0; rd < 3; ++rd) {
            const int r0 = rd * 6, nr = rd < 2 ? 6 : 5;
            __syncthreads();
            if (tid < 510) {
#pragma unroll
                for (int bb = 0; bb < 6; ++bb) if (bb < nr) *(float4*)(red + ((ks * 6 + cg) * 24 + bb * 4)) = make_float4(acc[r0 + bb][0], acc[r0 + bb][1], acc[r0 + bb][2], acc[r0 + bb][3]);
            }
            __syncthreads();
            if (tid < 6 * nr * 4) {
                const int ocg = tid / (nr * 4), rem = tid % (nr * 4), bb = rem >> 2, j = rem & 3;
                float s = 0.f;
                for (int q = 0; q < 85; ++q) s += red[(q * 6 + ocg) * 24 + bb * 4 + j];
                const int col = cb * 24 + ocg * 4 + j;
                mod[(r0 + bb) * 6144 + col] = s + b_ada[col];
            }
        }
        __syncthreads();
    }
}

__device__ __forceinline__ Ctx make_ctx() {
    Ctx c; int t = threadIdx.x; asm volatile("" : "+v"(t));
    c.tid = t; c.lane = t & 63; c.wib = t >> 6;
    c.gthr = blockIdx.x * NTHR + t; c.nthr = gridDim.x * NTHR;
    c.gwave = blockIdx.x * (NTHR / 64) + c.wib; c.nwave = gridDim.x * (NTHR / 64);
    return c;
}
__global__ void __launch_bounds__(NTHR) mega(Params p) {
    extern __shared__ __attribute__((aligned(16))) char lds[];
    cg::grid_group grid = cg::this_grid();
    Ctx cx = make_ctx();
    const float* x = p.in[0]; const float* c = p.in[1]; const float* ctx = p.in[2]; const float* c_ctx = p.in[3];
    const float* w_ada = p.in[4]; const float* b_ada = p.in[5]; const float* g_norm1 = p.in[6]; const float* w_in = p.in[7];
    const float* pool_w = p.in[8]; const float* pool_scale = p.in[9]; const float* g_q_lora = p.in[10]; const float* w_q_up = p.in[11];
    const float* g_kv_lora = p.in[12]; const float* w_kv_up = p.in[13]; const float* g_qk_q = p.in[14]; const float* g_qk_k = p.in[15];
    const float* w_out = p.in[16]; const float* g_norm2 = p.in[17]; const float* peer_w_q = p.in[18]; const float* sub_keys = p.in[19];
    const float* peer_u = p.in[20]; const float* peer_v = p.in[21];
    float* out = p.out; char* ws = p.ws;
    float* mod = (float*)(ws + WS_MOD);
    float* rope = (float*)(ws + WS_ROPE);
    bf16_t* h1 = (bf16_t*)(ws + WS_H1);
    bf16_t* proj = (bf16_t*)(ws + WS_PROJ);
    bf16_t* pm = (bf16_t*)(ws + WS_PM);
    bf16_t* cqn = (bf16_t*)(ws + WS_CQN);
    bf16_t* ckvn = (bf16_t*)(ws + WS_CKVN);
    bf16_t* kvraw = (bf16_t*)(ws + WS_KVRAW);
    bf16_t* Qb = (bf16_t*)(ws + WS_Q);
    bf16_t* Kb = (bf16_t*)(ws + WS_K);
    bf16_t* Vb = (bf16_t*)(ws + WS_V);
    bf16_t* mixin = (bf16_t*)(ws + WS_MIXIN);
    float* mixf = (float*)(ws + WS_MIXF);
    bf16_t* h2 = (bf16_t*)(ws + WS_H2);
    bf16_t* qp = (bf16_t*)(ws + WS_QP);
    int* eidx = (int*)(ws + WS_EIDX);
    float* gates = (float*)(ws + WS_GATES);

    bf16_t* wt_in = (bf16_t*)(ws + WS_WT_IN);
    bf16_t* wt_q = (bf16_t*)(ws + WS_WT_Q);
    bf16_t* wt_kv = (bf16_t*)(ws + WS_WT_KV);
    bf16_t* wt_out = (bf16_t*)(ws + WS_WT_OUT);
    bf16_t* wt_pq = (bf16_t*)(ws + WS_WT_PQ);
    unsigned char* u8 = (unsigned char*)(ws + WS_U8); unsigned char* v8 = (unsigned char*)(ws + WS_V8);
    float* su = (float*)(ws + WS_SU); float* sv = (float*)(ws + WS_SV);

    volatile XB_LAS unsigned* bst = (volatile XB_LAS unsigned*)(lds + LDS_BYTES - 16);
    if (cx.tid < 4) bst[cx.tid] = 0u;
    __syncthreads();
    volatile int* ctl = (volatile int*)(lds + LDS_BYTES - 32);
    XcdBarrier bar; bar.bar = (unsigned*)(ws + WS_BAR); bar.x = xb_xcc_id(); bar.st = bst;
    if (cx.tid == 0) ctl[0] = (int)xb_add(&bar.bar[XB_XCNT(bar.x)], 1u);

    ph_mod2(cx, lds, c, c_ctx, w_ada, b_ada, mod, rope);
    ph_wt_all(cx, lds, w_in, w_q_up, w_kv_up, w_out, peer_w_q, wt_in, wt_q, wt_kv, wt_out, wt_pq);
    ph_fold(cx, lds, pool_w, pool_scale, w_out, wt_out);
    ph_cvt8n(cx, peer_u, peer_v, u8, v8, su, sv);
    if (gridDim.y == 0x7fffu) grid.sync();
    xcd_barrier(bar); cx = make_ctx();
    if (cx.tid == 0) {
        int cntx = 0, below = 0, nxx = 0;
        for (unsigned jx = 0; jx < 16; ++jx) { const int cc = (int)xb_ld(&bar.bar[XB_XCNT(jx)]); if (cc > 0) { ++nxx; if (jx < bar.x) ++below; } if (jx == bar.x) cntx = cc; }
        ctl[1] = cntx > 0 ? cntx : 1; ctl[2] = below; ctl[3] = nxx > 0 ? nxx : 1;
    }
    __syncthreads();
    ph_h1(cx, x, ctx, g_norm1, mod, h1);
    xcd_barrier(bar); cx = make_ctx();
    run_gemm(lds, h1, wt_in, TA, PLD, D, pg8::EpiBf16{proj, PLD});
    xcd_barrier(bar); cx = make_ctx();
    ph_pm8(cx, proj, mixin);
    ph_rms2(cx, proj, g_q_lora, g_kv_lora, cqn, ckvn);
    xcd_barrier(bar); cx = make_ctx();
    run_gemm(lds, cqn, wt_q, T, 768, QL, pg8::EpiBf16{Qb, 768});
    run_gemm(lds, ckvn, wt_kv, TA, 1024, KVL, pg8::EpiKV{Kb, Vb}, true);
    xcd_barrier(bar); cx = make_ctx();
    ph_kfin(cx, proj, g_qk_k, rope, Kb);
    xcd_barrier(bar); cx = make_ctx();
    ph_attn_mfma(lds, Qb, Kb, Vb, mixin, g_qk_q, rope);
    xcd_barrier(bar); cx = make_ctx();
    bf16_t* mixb = (bf16_t*)(ws + WS_H1);
    run_gemm(lds, mixin, wt_out, T, D, D, pg8::EpiBf16{mixb, D});
    xcd_barrier(bar); cx = make_ctx();
    unsigned* hqn = (unsigned*)(ws + WS_MIXIN);
    float* hs = (float*)(ws + WS_MIXIN + (size_t)T * 1024);
    ph_h2(cx, x, mixb, mod, g_norm2, out, h2, hqn, hs);
    xcd_barrier(bar); cx = make_ctx();
    run_gemm(lds, h2, wt_pq, T, 2048, D, pg8::EpiBf16{qp, 2048});
    xcd_barrier(bar); cx = make_ctx();
    tk::ph_topk_mfma(cx, lds, qp, sub_keys, eidx, gates);
    xcd_barrier(bar); cx = make_ctx();
    float* pa = (float*)(ws + WS_Q);
    float* cbuf = (float*)(ws + WS_PM + (size_t)T * 128 * 4);
    ph_peer_u(cx, __builtin_amdgcn_readfirstlane(ctl[0]), __builtin_amdgcn_readfirstlane(ctl[1]), __builtin_amdgcn_readfirstlane(ctl[2]), __builtin_amdgcn_readfirstlane(ctl[3]), hqn, hs, eidx, u8, pa);
    xcd_barrier(bar); cx = make_ctx();
    ph_peer_r4(cx, lds, pa, eidx, gates, su, (unsigned*)cbuf, cbuf + (size_t)T * 64);
    xcd_barrier(bar); cx = make_ctx();
    ph_peer_v4(cx, lds, __builtin_amdgcn_readfirstlane(ctl[0]), __builtin_amdgcn_readfirstlane(ctl[1]), __builtin_amdgcn_readfirstlane(ctl[2]), __builtin_amdgcn_readfirstlane(ctl[3]), eidx, (const unsigned*)cbuf, cbuf + (size_t)T * 64, v8, mod, x, mixb, out);
}

extern "C" void kernel_launch(void* const* d_in, const int* in_sizes, int n_in, void* d_out, int out_size, void* d_ws, size_t ws_size, hipStream_t stream) {
    static int grid_blocks = 0;
    if (!grid_blocks) {
        int dev = 0, cus = 0, per_cu = 0;
        (void)hipGetDevice(&dev);
        (void)hipDeviceGetAttribute(&cus, hipDeviceAttributeMultiprocessorCount, dev);
        (void)hipFuncSetAttribute((const void*)mega, hipFuncAttributeMaxDynamicSharedMemorySize, LDS_BYTES);
        (void)hipOccupancyMaxActiveBlocksPerMultiprocessor(&per_cu, mega, NTHR, LDS_BYTES);
        if (per_cu < 1) per_cu = 1;
        grid_blocks = cus * per_cu;
        if (ws_size < WS_END2) fprintf(stderr, "kernel_launch: workspace too small: %zu < %zu\n", ws_size, (size_t)WS_END2);
    }
    (void)hipMemsetAsync((char*)d_ws + WS_BAR, 0, XCD_BAR_WORDS * 4, stream);
    Params p{};
    for (int i = 0; i < 22; ++i) p.in[i] = (const float*)d_in[i];
    p.out = (float*)d_out; p.ws = (char*)d_ws;
    void* args[] = {&p};
    hipError_t e = hipLaunchCooperativeKernel((const void*)mega, dim3(grid_blocks), dim3(NTHR), args, LDS_BYTES, stream);
    if (e != hipSuccess) fprintf(stderr, "cooperative launch failed: %s (grid %d)\n", hipGetErrorString(e), grid_blocks);
}
```

```cpp
#include <hip/hip_runtime.h>
#include <hip/hip_cooperative_groups.h>
#include <stdint.h>
#include <stdio.h>
#include <math.h>
namespace cg = cooperative_groups;

typedef unsigned short bf16_t;

constexpr int D = 1024, NB = 16, S = 2048, T = NB * S, CTXL = 256, TC = NB * CTXL, TA = T + TC;
constexpr int INW = 1184, PW = 512, QL = 384, KVL = 256, ROPE = 32, NOPE = 64, QKH = 96, VH = 64, NH = 8;
constexpr int SKV = S + CTXL;
constexpr int PLD = 1280;
constexpr int O_CQ = 512, O_CKV = 896, O_KR = 1152;
constexpr float EPS = 1e-6f;
constexpr int NTHR = 512;

constexpr size_t MB = 1024 * 1024;
constexpr size_t WS_MOD = 0;
constexpr size_t WS_ROPE = 512 * 1024;
constexpr size_t WS_BAR = 768 * 1024;
constexpr size_t WS_H1 = 1 * MB;
constexpr size_t SZ_H1 = (size_t)TA * 1024 * 2;
constexpr size_t WS_PROJ = WS_H1 + SZ_H1;
constexpr size_t SZ_PROJ = (size_t)TA * PLD * 2;
constexpr size_t WS_PM = WS_PROJ + SZ_PROJ;
constexpr size_t SZ_PM = (size_t)T * 512 * 2;
constexpr size_t WS_CQN = WS_PM + SZ_PM;
constexpr size_t SZ_CQN = (size_t)T * 384 * 2;
constexpr size_t WS_CKVN = WS_CQN + SZ_CQN;
constexpr size_t SZ_CKVN = (size_t)TA * 256 * 2;
constexpr size_t WS_Q = WS_CKVN + SZ_CKVN;
constexpr size_t SZ_Q = (size_t)T * 768 * 2;
constexpr size_t WS_K = WS_Q + SZ_Q;
constexpr size_t SZ_K = (size_t)NB * NH * SKV * 96 * 2;
constexpr size_t WS_V = WS_K + SZ_K;
constexpr size_t SZ_V = (size_t)NB * NH * SKV * 64 * 2;
constexpr size_t WS_MIXIN = WS_V + SZ_V;
constexpr size_t SZ_MIXIN = (size_t)T * 1024 * 2;
constexpr size_t WS_END = WS_MIXIN + SZ_MIXIN;
constexpr size_t WS_KVRAW = WS_H1;
constexpr size_t WS_MIXF = WS_Q;
constexpr size_t WS_H2 = WS_PROJ;
constexpr size_t WS_QP = WS_Q;
constexpr size_t WS_EIDX = WS_PM;
constexpr size_t WS_GATES = WS_CQN;
static_assert(SZ_Q + SZ_K + SZ_V >= (size_t)T * 1024 * 4, "mixf fits");
static_assert(SZ_PM >= (size_t)T * 128 * 8 && SZ_CQN >= (size_t)T * 128 * 4, "eidx+cbuf / gates fit");
static_assert(SZ_H1 >= (size_t)T * 1024 * 2, "mixb fits");
static_assert(WS_END <= 512 * MB, "workspace");

constexpr size_t WS_WT_IN = WS_END;
constexpr size_t WS_WT_Q = WS_WT_IN + (size_t)1280 * 1024 * 2;
constexpr size_t WS_WT_KV = WS_WT_Q + (size_t)768 * 384 * 2;
constexpr size_t WS_WT_OUT = WS_WT_KV + (size_t)1024 * 256 * 2;
constexpr size_t WS_WT_PQ = WS_WT_OUT + (size_t)1024 * 1024 * 2;
constexpr size_t WS_U8 = WS_WT_PQ + (size_t)2048 * 1024 * 2;
constexpr size_t WS_V8 = WS_U8 + (size_t)16384 * 1024;
constexpr size_t WS_SU = WS_V8 + (size_t)16384 * 1024;
constexpr size_t WS_SV = WS_SU + (size_t)16384 * 4;
constexpr size_t WS_END2 = WS_SV + (size_t)16384 * 4;
static_assert(WS_END2 <= 512 * MB, "workspace");

constexpr int LDS_BYTES = 144 * 1024;

__device__ __forceinline__ float bf2f(bf16_t v) { return __uint_as_float(((unsigned)v) << 16); }
__device__ __forceinline__ bf16_t f2bf(float f) { unsigned u = __float_as_uint(f); return (bf16_t)((u + 0x7fffu + ((u >> 16) & 1u)) >> 16); }
__device__ __forceinline__ float toF(float v) { return v; }
__device__ __forceinline__ float toF(bf16_t v) { return bf2f(v); }
__device__ __forceinline__ void fromF(float& d, float v) { d = v; }
__device__ __forceinline__ void fromF(bf16_t& d, float v) { d = f2bf(v); }
__device__ __forceinline__ float wave_max(float v) {
#pragma unroll
    for (int o = 32; o > 0; o >>= 1) v = fmaxf(v, __shfl_xor(v, o));
    return v;
}
__device__ __forceinline__ float wave_sum(float v) {
#pragma unroll
    for (int o = 32; o > 0; o >>= 1) v += __shfl_xor(v, o);
    return v;
}

__device__ __forceinline__ void unpack8(const uint4& v, float* f) {
    f[0] = __uint_as_float(v.x << 16); f[1] = __uint_as_float(v.x & 0xffff0000u); f[2] = __uint_as_float(v.y << 16); f[3] = __uint_as_float(v.y & 0xffff0000u);
    f[4] = __uint_as_float(v.z << 16); f[5] = __uint_as_float(v.z & 0xffff0000u); f[6] = __uint_as_float(v.w << 16); f[7] = __uint_as_float(v.w & 0xffff0000u);
}
__device__ __forceinline__ uint4 pack8(const float* f) {
    uint4 o;
    o.x = (unsigned)f2bf(f[0]) | ((unsigned)f2bf(f[1]) << 16); o.y = (unsigned)f2bf(f[2]) | ((unsigned)f2bf(f[3]) << 16);
    o.z = (unsigned)f2bf(f[4]) | ((unsigned)f2bf(f[5]) << 16); o.w = (unsigned)f2bf(f[6]) | ((unsigned)f2bf(f[7]) << 16);
    return o;
}

__device__ __forceinline__ float sum8_dpp(float d) {
    d += __int_as_float(__builtin_amdgcn_update_dpp(0, __float_as_int(d), 0xB1, 0xF, 0xF, true));
    d += __int_as_float(__builtin_amdgcn_update_dpp(0, __float_as_int(d), 0x4E, 0xF, 0xF, true));
    d += __int_as_float(__builtin_amdgcn_update_dpp(0, __float_as_int(d), 0x141, 0xF, 0xF, true));
    return d;
}

struct Params {
    const float* in[22];
    float* out;
    char* ws;
};
struct Ctx {
    int tid, lane, wib, gthr, nthr, gwave, nwave;
};

template <bool RES>
__device__ __forceinline__ void norm_mod_rows4(int lane, const float* const (&src)[4], const float* const (&md)[4], int shift_off, int scale_off, const float* __restrict__ g, bf16_t* const (&dst)[4],
                                               const bf16_t* const (&mix)[4], int gate_off, float* const (&xout)[4], unsigned* const (&hq)[4], float* const (&hsc)[4], float wscale = 1.0f) {
    float4 v[4][4];
    if (!RES) {
#pragma unroll
        for (int u = 0; u < 4; ++u)
#pragma unroll
            for (int hlf = 0; hlf < 2; ++hlf) { v[u][hlf * 2] = *(const float4*)(src[u] + hlf * 512 + lane * 8); v[u][hlf * 2 + 1] = *(const float4*)(src[u] + hlf * 512 + lane * 8 + 4); }
    } else {
        uint4 mx[4][2];
#pragma unroll
        for (int u = 0; u < 4; ++u)
#pragma unroll
            for (int hlf = 0; hlf < 2; ++hlf) mx[u][hlf] = *(const uint4*)(mix[u] + hlf * 512 + lane * 8);
#pragma unroll
        for (int u = 0; u < 4; ++u)
#pragma unroll
            for (int hlf = 0; hlf < 2; ++hlf) {
                float m[8]; unpack8(mx[u][hlf], m);
                v[u][hlf * 2] = make_float4(m[0], m[1], m[2], m[3]); v[u][hlf * 2 + 1] = make_float4(m[4], m[5], m[6], m[7]);
            }
        (void)xout; (void)gate_off;
    }
    float4 gg[4];
#pragma unroll
    for (int hlf = 0; hlf < 2; ++hlf) { gg[hlf * 2] = *(const float4*)(g + hlf * 512 + lane * 8); gg[hlf * 2 + 1] = *(const float4*)(g + hlf * 512 + lane * 8 + 4); }
#pragma unroll
    for (int u = 0; u < 4; ++u) {
        float ss = 0.f;
#pragma unroll
        for (int i = 0; i < 4; ++i) ss += v[u][i].x * v[u][i].x + v[u][i].y * v[u][i].y + v[u][i].z * v[u][i].z + v[u][i].w * v[u][i].w;
        ss = wave_sum(ss);
        const float rstd = rsqrtf(ss / (float)D + EPS);
        float fq[16]; float amax = 0.f;
#pragma unroll
        for (int hlf = 0; hlf < 2; ++hlf) {
            const int col = hlf * 512 + lane * 8;
            const float4 s0 = *(const float4*)(md[u] + scale_off + col), s1 = *(const float4*)(md[u] + scale_off + col + 4);
            const float4 h0 = *(const float4*)(md[u] + shift_off + col), h1v = *(const float4*)(md[u] + shift_off + col + 4);
            const float4 a = v[u][hlf * 2], bq = v[u][hlf * 2 + 1], g0 = gg[hlf * 2], g1 = gg[hlf * 2 + 1];
            float f[8];
            f[0] = a.x * rstd * g0.x * (1.0f + s0.x) + h0.x; f[1] = a.y * rstd * g0.y * (1.0f + s0.y) + h0.y; f[2] = a.z * rstd * g0.z * (1.0f + s0.z) + h0.z; f[3] = a.w * rstd * g0.w * (1.0f + s0.w) + h0.w;
            f[4] = bq.x * rstd * g1.x * (1.0f + s1.x) + h1v.x; f[5] = bq.y * rstd * g1.y * (1.0f + s1.y) + h1v.y; f[6] = bq.z * rstd * g1.z * (1.0f + s1.z) + h1v.z; f[7] = bq.w * rstd * g1.w * (1.0f + s1.w) + h1v.w;
#pragma unroll
            for (int i = 0; i < 8; ++i) { fq[hlf * 8 + i] = RES ? bf2f(f2bf(f[i])) : f[i]; amax = fmaxf(amax, fabsf(fq[hlf * 8 + i])); }
        }
        if (!RES) {
            amax = wave_max(amax);
            const float sh = amax > 0.f ? amax * (1.0f / 127.0f) : 1.0f, ish = 1.0f / sh;
#pragma unroll
            for (int hlf = 0; hlf < 2; ++hlf) {
                unsigned b0 = 0u, b1 = 0u;
#pragma unroll
                for (int i = 0; i < 8; ++i) { int h8 = (int)rintf(fq[hlf * 8 + i] * ish); h8 = h8 < -127 ? -127 : (h8 > 127 ? 127 : h8);
                    if (i < 4) b0 |= ((unsigned)h8 & 0xFFu) << (8 * i); else b1 |= ((unsigned)h8 & 0xFFu) << (8 * (i - 4)); }
                *(uint2*)((unsigned char*)dst[u] + hlf * 512 + lane * 8) = make_uint2(b0, b1);
            }
            if (lane == 0) hsc[u][0] = sh * wscale;
        }
        if (RES) {
            amax = wave_max(amax);
            const float sh = amax > 0.f ? amax * (1.0f / 119.0f) : 1.0f, ish = 1.0f / sh;
#pragma unroll
            for (int hlf = 0; hlf < 2; ++hlf) {
                unsigned whi = 0u, wlo = 0u, b0 = 0u, b1 = 0u;
#pragma unroll
                for (int i = 0; i < 8; ++i) {
                    int h8 = (int)rintf(fq[hlf * 8 + i] * ish); h8 = h8 < -119 ? -119 : (h8 > 119 ? 119 : h8);
                    const int lo = ((h8 + 8) & 15) - 8, hi = (h8 - lo) >> 4;
                    whi |= ((unsigned)hi & 0xFu) << (4 * i); wlo |= ((unsigned)lo & 0xFu) << (4 * i);
                    if (i < 4) b0 |= ((unsigned)h8 & 0xFFu) << (8 * i); else b1 |= ((unsigned)h8 & 0xFFu) << (8 * (i - 4));
                }
                hq[u][hlf * 64 + lane] = whi; hq[u][128 + hlf * 64 + lane] = wlo;
                *(uint2*)((unsigned char*)dst[u] + hlf * 512 + lane * 8) = make_uint2(b0, b1);
            }
            if (lane == 0) hsc[u][0] = sh;
        }
    }
}
__device__ __forceinline__ void ph_h1(const Ctx& cx, const float* __restrict__ x, const float* __restrict__ ctx, const float* __restrict__ g, const float* __restrict__ mod, signed char* __restrict__ h1q,
                                      float* __restrict__ hs1, const unsigned* __restrict__ wmax_in) {
    const float wscale = __uint_as_float(*(const volatile unsigned*)wmax_in) * (1.0f / 127.0f);
    for (int rb = cx.gwave * 4; rb < TA; rb += cx.nwave * 4) {
        const float* src[4]; const float* md[4]; bf16_t* dst[4]; float* hs4[4];
#pragma unroll
        for (int u = 0; u < 4; ++u) {
            const int r = rb + u;
            if (r < T) { src[u] = x + (size_t)r * D; md[u] = mod + (r / S) * 6144; } else { src[u] = ctx + (size_t)(r - T) * D; md[u] = mod + 16 * 6144; }
            dst[u] = (bf16_t*)(h1q + (size_t)r * D); hs4[u] = hs1 + r;
        }
        const bf16_t* nomix[4] = {nullptr, nullptr, nullptr, nullptr}; float* noout[4] = {nullptr, nullptr, nullptr, nullptr};
        unsigned* nohq[4] = {nullptr, nullptr, nullptr, nullptr};
        norm_mod_rows4<false>(cx.lane, src, md, 0, D, g, dst, nomix, 0, noout, nohq, hs4, wscale);
    }
}


namespace pg8 {
#define PG8_LAS __attribute__((address_space(3)))
typedef short bf16x8 __attribute__((ext_vector_type(8)));
typedef float f32x4 __attribute__((ext_vector_type(4)));
typedef unsigned u32x4 __attribute__((ext_vector_type(4)));
typedef int i32x4g __attribute__((ext_vector_type(4)));
constexpr int BM = 256, BK = 64, HALF = 128, HTB = HALF * BK * 2, STAGE_BYTES = 8 * HTB, NXCD = 8, WGM = 8;
__host__ __device__ __forceinline__ int lds_byte(int r, int c) { const int st = (r >> 4) * 2 + (c >> 5), rr = r & 15, cc = c & 31, ob = rr * 64 + cc * 2; return st * 1024 + (ob ^ (((ob >> 9) & 1) << 5)); }
__host__ __device__ __forceinline__ void stage_rc(int b, int& R, int& C) { const int st = b / 1024, sb = b % 1024, swz = sb ^ (((sb >> 9) & 1) << 5); R = (st >> 1) * 16 + swz / 64; C = (st & 1) * 32 + (swz % 64) / 2; }
__host__ __device__ __forceinline__ int perm32(int rho) { const int n = rho >> 4, i = rho & 15; return 8 * (i >> 2) + 4 * n + (i & 3); }
struct Unit { int pm, pn; };
struct Gemm { const bf16_t* A; const bf16_t* Bt; int M, N, K; };
struct StaticOrder {
    int nM, nN, nwg, G, c;
    __host__ __device__ void init(int M, int N, int G_, int c_) { nM = M / BM; nN = N / BM; nwg = nM * nN; G = G_; c = c_; }
    __host__ __device__ bool next(int i, Unit& u) const {
        const long L = (long)i * G + c; if (L >= nwg) return false;
        int wgid = (int)L; { const int q = nwg / NXCD, r = nwg % NXCD, xcd = wgid % NXCD, off = wgid / NXCD; wgid = (xcd < r ? xcd * (q + 1) : r * (q + 1) + (xcd - r) * q) + off; }
        const int nig = WGM * nN, gid = wgid / nig, fm = gid * WGM, gsz = (nM - fm) < WGM ? (nM - fm) : WGM;
        u.pm = fm + ((wgid % nig) % gsz); u.pn = (wgid % nig) / gsz; return true;
    }
    __device__ __forceinline__ void a_ready(const Unit&) const {}
    __device__ __forceinline__ void done(const Unit&) const {}
};
__device__ __forceinline__ unsigned cvt_pk_bf16(float lo, float hi) { unsigned r; asm volatile("v_cvt_pk_bf16_f32 %0, %1, %2" : "=v"(r) : "v"(lo), "v"(hi)); return r; }
struct EpiBf16 {
    static constexpr bool PERM = true, AFTER_DRAIN = false;
    bf16_t* O; int ldc;
    __device__ __forceinline__ void operator()(const f32x4 (&acc)[2][2][4][2], const Unit& u, int wr, int wc, int fr, int fq) const {
        const int row0 = u.pm * BM + wr * 64 + fr, col0 = u.pn * BM + wc * 32 + 8 * fq;
#pragma unroll
        for (int ai = 0; ai < 2; ++ai)
#pragma unroll
            for (int m = 0; m < 4; ++m) { bf16_t* rowp = O + (size_t)(row0 + ai * HALF + m * 16) * ldc + col0;
#pragma unroll
                for (int bj = 0; bj < 2; ++bj) { const f32x4 v0 = acc[ai][bj][m][0], v1 = acc[ai][bj][m][1];
                    u32x4 w; w.x = cvt_pk_bf16(v0[0], v0[1]); w.y = cvt_pk_bf16(v0[2], v0[3]); w.z = cvt_pk_bf16(v1[0], v1[1]); w.w = cvt_pk_bf16(v1[2], v1[3]);
                    *(u32x4*)(rowp + bj * HALF) = w; } }
    }
};
struct EpiI8 {
    static constexpr bool PERM = true, AFTER_DRAIN = false;
    bf16_t* O; int ldc;
    __device__ __forceinline__ void operator()(const f32x4 (&acc)[2][2][4][2], const Unit& u, int wr, int wc, int fr, int fq) const {
        const int row0 = u.pm * BM + wr * 64 + fr, col0 = u.pn * BM + wc * 32 + 8 * fq;
#pragma unroll
        for (int ai = 0; ai < 2; ++ai)
#pragma unroll
            for (int m = 0; m < 4; ++m) { bf16_t* rowp = O + (size_t)(row0 + ai * HALF + m * 16) * ldc + col0;
#pragma unroll
                for (int bj = 0; bj < 2; ++bj) { const i32x4g v0 = __builtin_bit_cast(i32x4g, acc[ai][bj][m][0]), v1 = __builtin_bit_cast(i32x4g, acc[ai][bj][m][1]);
                    u32x4 w; w.x = cvt_pk_bf16((float)v0[0], (float)v0[1]); w.y = cvt_pk_bf16((float)v0[2], (float)v0[3]); w.z = cvt_pk_bf16((float)v1[0], (float)v1[1]); w.w = cvt_pk_bf16((float)v1[2], (float)v1[3]);
                    *(u32x4*)(rowp + bj * HALF) = w; } }
    }
};
struct EpiI8S {
    static constexpr bool PERM = true, AFTER_DRAIN = false;
    bf16_t* O; int ldc; const float* rs;
    __device__ __forceinline__ void operator()(const f32x4 (&acc)[2][2][4][2], const Unit& u, int wr, int wc, int fr, int fq) const {
        const int row0 = u.pm * BM + wr * 64 + fr, col0 = u.pn * BM + wc * 32 + 8 * fq;
        float sc[8];
#pragma unroll
        for (int i = 0; i < 8; ++i) sc[i] = *(const float*)((const char*)rs + (unsigned)((row0 + (i >> 2) * HALF + (i & 3) * 16) * 4));
        unsigned off = (unsigned)(row0 * ldc + col0) * 2u;
#pragma unroll
        for (int ai = 0; ai < 2; ++ai)
#pragma unroll
            for (int m = 0; m < 4; ++m) {
                const float scv = sc[ai * 4 + m];
#pragma unroll
                for (int bj = 0; bj < 2; ++bj) { const i32x4g v0 = __builtin_bit_cast(i32x4g, acc[ai][bj][m][0]), v1 = __builtin_bit_cast(i32x4g, acc[ai][bj][m][1]);
                    u32x4 w; w.x = cvt_pk_bf16((float)v0[0] * scv, (float)v0[1] * scv); w.y = cvt_pk_bf16((float)v0[2] * scv, (float)v0[3] * scv);
                    w.z = cvt_pk_bf16((float)v1[0] * scv, (float)v1[1] * scv); w.w = cvt_pk_bf16((float)v1[2] * scv, (float)v1[3] * scv);
                    *(u32x4*)((char*)O + (unsigned)(off + (unsigned)(bj * HALF * 2))) = w; }
                off += (m == 3 ? (unsigned)(HALF - 48) : 16u) * (unsigned)ldc * 2u;
            }
    }
};
struct EpiKV {
    static constexpr bool PERM = true, AFTER_DRAIN = false;
    bf16_t* Kb; bf16_t* Vb;
    __device__ __forceinline__ void operator()(const f32x4 (&acc)[2][2][4][2], const Unit& u, int wr, int wc, int fr, int fq) const {
        const bool lat = u.pm < (T / BM);
        const int b = lat ? (u.pm >> 3) : (u.pm - T / BM), key0 = (lat ? (u.pm & 7) * BM : S) + wr * 64 + fr;
        const int dc = (wc & 1) * 32 + 8 * fq, rec0 = (b * NH + 2 * u.pn) * SKV + key0;
        const bool isv = wc >= 2;
        const unsigned rs2 = isv ? 128u : 192u;
        char* dst = isv ? (char*)Vb : (char*)Kb;
        unsigned off = (unsigned)rec0 * rs2 + (unsigned)dc * 2u;
#pragma unroll
        for (int ai = 0; ai < 2; ++ai)
#pragma unroll
            for (int m = 0; m < 4; ++m) {
#pragma unroll
                for (int bj = 0; bj < 2; ++bj) { const f32x4 v0 = acc[ai][bj][m][0], v1 = acc[ai][bj][m][1];
                    u32x4 w; w.x = cvt_pk_bf16(v0[0], v0[1]); w.y = cvt_pk_bf16(v0[2], v0[3]); w.z = cvt_pk_bf16(v1[0], v1[1]); w.w = cvt_pk_bf16(v1[2], v1[3]);
                    *(u32x4*)(dst + (unsigned)(off + (bj ? (unsigned)SKV * rs2 : 0u))) = w; __builtin_amdgcn_sched_barrier(0); }
                off += (m == 3 ? (unsigned)(HALF - 48) : 16u) * rs2;
                asm volatile("" : "+v"(off));
            }
    }
};
struct EpiX1b {
    static constexpr bool PERM = true, AFTER_DRAIN = false;
    const float* x; const float* mod; bf16_t* O;
    __device__ __forceinline__ void operator()(const f32x4 (&acc)[2][2][4][2], const Unit& u, int wr, int wc, int fr, int fq) const {
        const int row0 = u.pm * BM + wr * 64 + fr, col0 = u.pn * BM + wc * 32 + 8 * fq;
        const float* gate = mod + (size_t)((u.pm * BM) >> 11) * 6144 + 2048;
        f32x4 gv[2][2];
#pragma unroll
        for (int bj = 0; bj < 2; ++bj)
#pragma unroll
            for (int n = 0; n < 2; ++n) gv[bj][n] = *(const f32x4*)(gate + col0 + bj * HALF + n * 4);
        f32x4 xb[2][2][2][2];
#define X1_LOAD(buf, k) do { _Pragma("unroll") for (int mm = 0; mm < 2; ++mm) _Pragma("unroll") for (int bj = 0; bj < 2; ++bj) _Pragma("unroll") for (int n = 0; n < 2; ++n) \
            xb[buf][mm][bj][n] = *(const f32x4*)((const char*)x + (unsigned)((((row0 + ((k) >> 1) * HALF + (((k) & 1) * 2 + mm) * 16) * 1024) + col0 + bj * HALF + n * 4) * 4)); } while (0)
#define X1_DO(buf, k) do { _Pragma("unroll") for (int mm = 0; mm < 2; ++mm) _Pragma("unroll") for (int bj = 0; bj < 2; ++bj) { \
            const f32x4 v0 = xb[buf][mm][bj][0] + gv[bj][0] * acc[(k) >> 1][bj][((k) & 1) * 2 + mm][0], v1 = xb[buf][mm][bj][1] + gv[bj][1] * acc[(k) >> 1][bj][((k) & 1) * 2 + mm][1]; \
            u32x4 w; w.x = cvt_pk_bf16(v0[0], v0[1]); w.y = cvt_pk_bf16(v0[2], v0[3]); w.z = cvt_pk_bf16(v1[0], v1[1]); w.w = cvt_pk_bf16(v1[2], v1[3]); \
            *(u32x4*)((char*)O + (unsigned)((((row0 + ((k) >> 1) * HALF + (((k) & 1) * 2 + mm) * 16) * 1024) + col0 + bj * HALF) * 2)) = w; } } while (0)
        X1_LOAD(0, 0); X1_LOAD(1, 1); __builtin_amdgcn_sched_barrier(0);
        X1_DO(0, 0); __builtin_amdgcn_sched_barrier(0); X1_LOAD(0, 2); __builtin_amdgcn_sched_barrier(0);
        X1_DO(1, 1); __builtin_amdgcn_sched_barrier(0); X1_LOAD(1, 3); __builtin_amdgcn_sched_barrier(0);
        X1_DO(0, 2); __builtin_amdgcn_sched_barrier(0);
        X1_DO(1, 3);
#undef X1_LOAD
#undef X1_DO
    }
};
struct EpiResid {
    static constexpr bool PERM = false, AFTER_DRAIN = false;
    const float* x; const float* mod; float* out;
    __device__ __forceinline__ void operator()(const f32x4 (&acc)[2][2][4][2], const Unit& u, int wr, int wc, int fr, int fq) const {
        const int row0 = u.pm * BM + wr * 64 + fr, col0 = u.pn * BM + wc * 32 + 4 * fq;
        const float* gate = mod + (size_t)((u.pm * BM) >> 11) * 6144 + 2048;
        f32x4 gv[2][2];
#pragma unroll
        for (int bj = 0; bj < 2; ++bj)
#pragma unroll
            for (int n = 0; n < 2; ++n) gv[bj][n] = *(const f32x4*)(gate + col0 + bj * HALF + n * 16);
#pragma unroll
        for (int ai = 0; ai < 2; ++ai)
#pragma unroll
            for (int m = 0; m < 4; ++m) { const size_t off = (size_t)(row0 + ai * HALF + m * 16) * 1024 + col0;
#pragma unroll
                for (int bj = 0; bj < 2; ++bj)
#pragma unroll
                    for (int n = 0; n < 2; ++n) { const f32x4 xv = *(const f32x4*)(x + off + bj * HALF + n * 16); *(f32x4*)(out + off + bj * HALF + n * 16) = xv + gv[bj][n] * acc[ai][bj][m][n]; } }
    }
};
template <class Epi, class Sched, bool I8 = false>
__device__ __forceinline__ void gemm_phase(PG8_LAS unsigned char* lds, const Gemm g, const Sched& S, const Epi& E) {
    int tid_ = threadIdx.x; asm volatile("" : "+v"(tid_));
    const int tid = tid_, wid = __builtin_amdgcn_readfirstlane(tid >> 6), lane = tid & 63, wr = wid >> 2, wc = wid & 3, fr = lane & 15, fq = lane >> 4;
    const int K = g.K, nt = K / BK;
    unsigned voffA[2], voffB[2];
#pragma unroll
    for (int i = 0; i < 2; ++i) { int R, C; stage_rc(tid * 16 + i * 8192, R, C); const int Rb = Epi::PERM ? ((R & ~31) + perm32(R & 31)) : R;
        voffA[i] = (unsigned)(R * K + C) * 2u; voffB[i] = (unsigned)(Rb * K + C) * 2u; }
    const size_t kstep = (size_t)(BK * 2);
    const size_t hstep = (size_t)HALF * K * 2;
    const size_t tstep = 2 * hstep;
    const unsigned ldsw = (unsigned)wid * 1024u;
    const int aoff = lds_byte(wr * 64 + fr, fq * 8), boff = lds_byte(wc * 32 + fr, fq * 8);
#define PG8_SA(b, h) (((b) * 2 + (h)) * HTB)
#define PG8_SB(b, h) ((4 + (b) * 2 + (h)) * HTB)
#define PG8_STAGE(bufoff, gbase, voff) do { _Pragma("unroll") for (int _i = 0; _i < 2; ++_i) \
        __builtin_amdgcn_global_load_lds((const unsigned*)((const char*)(gbase) + (voff)[_i]), (PG8_LAS unsigned*)(lds + (bufoff) + ldsw + _i * 8192), 16, 0, 0); } while (0)
#define PG8_LDA(dst, b, h) do { _Pragma("unroll") for (int m = 0; m < 4; ++m) _Pragma("unroll") for (int k = 0; k < 2; ++k) dst[m][k] = *(const PG8_LAS bf16x8*)(lds + PG8_SA(b, h) + aoff + m * 2048 + k * 1024); } while (0)
#define PG8_LDB(dst, b, h) do { _Pragma("unroll") for (int n = 0; n < 2; ++n) _Pragma("unroll") for (int k = 0; k < 2; ++k) dst[n][k] = *(const PG8_LAS bf16x8*)(lds + PG8_SB(b, h) + boff + n * 2048 + k * 1024); } while (0)
#define PG8_MMA(ai, bj, At, Bt) do { __builtin_amdgcn_s_setprio(1); _Pragma("unroll") for (int m = 0; m < 4; ++m) _Pragma("unroll") for (int n = 0; n < 2; ++n) _Pragma("unroll") for (int k = 0; k < 2; ++k) { \
        if (I8) acc[ai][bj][m][n] = __builtin_bit_cast(f32x4, __builtin_amdgcn_mfma_i32_16x16x64_i8(__builtin_bit_cast(i32x4g, Bt[n][k]), __builtin_bit_cast(i32x4g, At[m][k]), __builtin_bit_cast(i32x4g, acc[ai][bj][m][n]), 0, 0, 0)); \
        else acc[ai][bj][m][n] = __builtin_amdgcn_mfma_f32_16x16x32_bf16(Bt[n][k], At[m][k], acc[ai][bj][m][n], 0, 0, 0); } __builtin_amdgcn_s_setprio(0); } while (0)
#define PG8_WAIT_V(n) asm volatile("s_waitcnt vmcnt(" #n ")" ::: "memory")
#define PG8_WAIT_L(n) asm volatile("s_waitcnt lgkmcnt(" #n ")" ::: "memory")
#define PG8_BAR __builtin_amdgcn_s_barrier()
#define PG8_SCHED __builtin_amdgcn_sched_barrier(0)
    Unit cur, nxt; int ui = 0;
    if (!S.next(0, cur)) return;
    f32x4 acc[2][2][4][2];
#pragma unroll
    for (int a = 0; a < 2; ++a)
#pragma unroll
        for (int b = 0; b < 2; ++b)
#pragma unroll
            for (int m = 0; m < 4; ++m)
#pragma unroll
                for (int n = 0; n < 2; ++n) acc[a][b][m][n] = (f32x4){0.f, 0.f, 0.f, 0.f};
    bf16x8 At[4][2], B0[2][2], B1[2][2];
    const char* cA = (const char*)g.A + (size_t)cur.pm * tstep; const char* cB = (const char*)g.Bt + (size_t)cur.pn * tstep;
    S.a_ready(cur);
    PG8_STAGE(PG8_SB(0, 0), cB, voffB); PG8_STAGE(PG8_SA(0, 0), cA, voffA); PG8_STAGE(PG8_SB(0, 1), cB + hstep, voffB); PG8_STAGE(PG8_SA(0, 1), cA + hstep, voffA);
    if (wr == 1) PG8_BAR;
    PG8_WAIT_V(4); PG8_BAR;
    PG8_STAGE(PG8_SB(1, 0), cB + kstep, voffB); PG8_STAGE(PG8_SA(1, 0), cA + kstep, voffA); PG8_STAGE(PG8_SB(1, 1), cB + hstep + kstep, voffB);
    PG8_WAIT_V(6); PG8_BAR;
    for (;;) {
        const bool has_next = S.next(ui + 1, nxt);
        const char* nA = has_next ? (const char*)g.A + (size_t)nxt.pm * tstep : cA; const char* nB = has_next ? (const char*)g.Bt + (size_t)nxt.pn * tstep : cB;
        for (int t = 0; t < nt; t += 2) {
            const bool last = (t == nt - 2);
            const char* a1 = cA + (size_t)(t + 1) * kstep;
            const char* a2 = last ? nA : cA + (size_t)(t + 2) * kstep; const char* b2 = last ? nB : cB + (size_t)(t + 2) * kstep;
            const char* a3 = a2 + kstep; const char* b3 = b2 + kstep;
            if (last && has_next) S.a_ready(nxt);
            PG8_LDB(B0, 0, 0); PG8_SCHED; PG8_LDA(At, 0, 0); PG8_STAGE(PG8_SA(1, 1), a1 + hstep, voffA);
            PG8_WAIT_L(8); PG8_BAR; PG8_WAIT_L(0); PG8_MMA(0, 0, At, B0); PG8_BAR; PG8_SCHED;
            PG8_LDB(B1, 0, 1); PG8_STAGE(PG8_SB(0, 0), b2, voffB);
            PG8_BAR; PG8_WAIT_L(0); PG8_MMA(0, 1, At, B1); PG8_BAR;
            PG8_LDA(At, 0, 1); PG8_STAGE(PG8_SA(0, 0), a2, voffA);
            PG8_BAR; PG8_WAIT_L(0); PG8_MMA(1, 0, At, B0); PG8_BAR; PG8_SCHED;
            PG8_STAGE(PG8_SB(0, 1), b2 + hstep, voffB);
            PG8_WAIT_V(6); PG8_BAR; PG8_MMA(1, 1, At, B1); PG8_BAR;
            PG8_LDB(B0, 1, 0); PG8_SCHED; PG8_LDA(At, 1, 0); PG8_STAGE(PG8_SA(0, 1), a2 + hstep, voffA);
            PG8_WAIT_L(8); PG8_BAR; PG8_WAIT_L(0); PG8_MMA(0, 0, At, B0); PG8_BAR; PG8_SCHED;
            PG8_LDB(B1, 1, 1); PG8_STAGE(PG8_SB(1, 0), b3, voffB);
            PG8_BAR; PG8_WAIT_L(0); PG8_MMA(0, 1, At, B1); PG8_BAR;
            PG8_LDA(At, 1, 1); PG8_STAGE(PG8_SA(1, 0), a3, voffA);
            PG8_BAR; PG8_WAIT_L(0); PG8_MMA(1, 0, At, B0); PG8_BAR; PG8_SCHED;
            PG8_STAGE(PG8_SB(1, 1), b3 + hstep, voffB);
            PG8_WAIT_V(6); PG8_BAR; PG8_MMA(1, 1, At, B1); PG8_BAR;
        }
        E(acc, cur, wr, wc, fr, fq); S.done(cur);
        if (!has_next) break;
#pragma unroll
        for (int a = 0; a < 2; ++a)
#pragma unroll
            for (int b = 0; b < 2; ++b)
#pragma unroll
                for (int m = 0; m < 4; ++m)
#pragma unroll
                    for (int n = 0; n < 2; ++n) acc[a][b][m][n] = (f32x4){0.f, 0.f, 0.f, 0.f};
        cur = nxt; cA = nA; cB = nB; ++ui;
    }
    PG8_WAIT_V(0);
    if (wr == 0) PG8_BAR;
    PG8_BAR;
#undef PG8_SA
#undef PG8_SB
#undef PG8_STAGE
#undef PG8_LDA
#undef PG8_LDB
#undef PG8_MMA
#undef PG8_WAIT_V
#undef PG8_WAIT_L
#undef PG8_BAR
#undef PG8_SCHED
}
}

template <class Epi>
__device__ __forceinline__ void run_gemm(char* lds, const bf16_t* A, const bf16_t* Bt, int M, int N, int K, const Epi& E, bool reverse = false) {
    pg8::Gemm g{A, Bt, M, N, K}; pg8::StaticOrder S; S.init(M, N, (int)gridDim.x, reverse ? (int)(gridDim.x - 1 - blockIdx.x) : (int)blockIdx.x);
    pg8::gemm_phase<Epi, pg8::StaticOrder>((PG8_LAS unsigned char*)lds, g, S, E);
}

template <class Epi>
__device__ __forceinline__ void run_gemm_i8(char* lds, const signed char* A8, const signed char* Bt8, int M, int N, int Kbytes, const Epi& E) {
    pg8::Gemm g{(const bf16_t*)A8, (const bf16_t*)Bt8, M, N, Kbytes / 2}; pg8::StaticOrder S; S.init(M, N, (int)gridDim.x, (int)blockIdx.x);
    pg8::gemm_phase<Epi, pg8::StaticOrder, true>((PG8_LAS unsigned char*)lds, g, S, E);
}
struct WtTile { const float* W; bf16_t* Wt; int N, ldt, koff, k0, n0; };
__device__ __forceinline__ WtTile wt_pick(int tI, const float* w_in, const float* w_q_up, const float* w_kv_up, const float* w_out, const float* peer_w_q,
                                          bf16_t* wt_in, bf16_t* wt_q, bf16_t* wt_kv, bf16_t* wt_out, bf16_t* wt_pq) {
    WtTile t; int ntk, loc;
    if (tI < 320)      { t.W = w_in;     t.Wt = wt_in;  t.N = INW;  t.ldt = 1024; t.koff = 0;   ntk = 16; loc = tI; }
    else if (tI < 392) { t.W = w_q_up;   t.Wt = wt_q;   t.N = 768;  t.ldt = QL;   t.koff = 0;   ntk = 6;  loc = tI - 320; }
    else if (tI < 456) { t.W = w_kv_up;  t.Wt = wt_kv;  t.N = 1024; t.ldt = KVL;  t.koff = 0;   ntk = 4;  loc = tI - 392; }
    else if (tI < 584) { t.W = w_out + (size_t)512 * 1024; t.Wt = wt_out; t.N = 1024; t.ldt = 1024; t.koff = 512; ntk = 8; loc = tI - 456; }
    else               { t.W = peer_w_q; t.Wt = wt_pq;  t.N = 2048; t.ldt = 1024; t.koff = 0;   ntk = 16; loc = tI - 584; }
    t.k0 = (loc % ntk) * 64; t.n0 = (loc / ntk) * 64;
    return t;
}
constexpr int WT_TILES = 320 + 72 + 64 + 128 + 512;
__device__ __forceinline__ void ph_wt_all(const Ctx& cx, char* lds, const float* w_in, const float* w_q_up, const float* w_kv_up, const float* w_out, const float* peer_w_q,
                                          bf16_t* wt_in, bf16_t* wt_q, bf16_t* wt_kv, bf16_t* wt_out, bf16_t* wt_pq, unsigned* wmax) {
    float (*tile)[64][65] = (float (*)[64][65])lds;
    const int G = (int)gridDim.x;
    float mxin = 0.f, mxpq = 0.f;
    for (int base = blockIdx.x; base < WT_TILES; base += 5 * G) {
        float v[5][8];
#pragma unroll
        for (int s5 = 0; s5 < 5; ++s5) {
            const int tI = base + s5 * G;
            if (tI < WT_TILES) {
                const WtTile t = wt_pick(tI, w_in, w_q_up, w_kv_up, w_out, peer_w_q, wt_in, wt_q, wt_kv, wt_out, wt_pq);
#pragma unroll
                for (int i = 0; i < 8; ++i) { const int e = cx.tid + 512 * i; const int kk = e >> 6, nn = e & 63; v[s5][i] = (t.n0 + nn < t.N) ? t.W[(size_t)(t.k0 + kk) * t.N + t.n0 + nn] : 0.f; }
                if (tI >= 584 || tI < 320) {
                    float mxw = 0.f;
#pragma unroll
                    for (int i = 0; i < 8; ++i) mxw = fmaxf(mxw, fabsf(v[s5][i]));
                    if (tI < 320) mxin = fmaxf(mxin, mxw); else mxpq = fmaxf(mxpq, mxw);
                }
            }
        }
        __syncthreads();
#pragma unroll
        for (int s5 = 0; s5 < 5; ++s5) {
            if (base + s5 * G < WT_TILES) {
#pragma unroll
                for (int i = 0; i < 8; ++i) { const int e = cx.tid + 512 * i; tile[s5][e >> 6][e & 63] = v[s5][i]; }
            }
        }
        __syncthreads();
#pragma unroll
        for (int s5 = 0; s5 < 5; ++s5) {
            const int tI = base + s5 * G;
            if (tI < WT_TILES) {
                const WtTile t = wt_pick(tI, w_in, w_q_up, w_kv_up, w_out, peer_w_q, wt_in, wt_q, wt_kv, wt_out, wt_pq);
#pragma unroll
                for (int i = 0; i < 4; ++i) {
                    const int e = cx.tid + 512 * i; const int nn = e >> 5, kp = e & 31;
                    *(unsigned*)(t.Wt + (size_t)(t.n0 + nn) * t.ldt + t.koff + t.k0 + 2 * kp) = (unsigned)f2bf(tile[s5][2 * kp][nn]) | ((unsigned)f2bf(tile[s5][2 * kp + 1][nn]) << 16);
                }
            }
        }
    }
    __syncthreads();
    {
        float* red = (float*)lds;
        mxin = wave_max(mxin); mxpq = wave_max(mxpq);
        if (cx.lane == 0) { red[cx.wib] = mxpq; red[8 + cx.wib] = mxin; }
        __syncthreads();
        if (cx.tid < 2) { float mv = 0.f;
#pragma unroll
            for (int w8 = 0; w8 < 8; ++w8) mv = fmaxf(mv, red[cx.tid * 8 + w8]);
            if (mv > 0.f) atomicMax(wmax + cx.tid, __float_as_uint(mv)); }
    }
    __syncthreads();
}

__device__ __forceinline__ void ph_wq8(const Ctx& cx, const bf16_t* __restrict__ wt_pq, const unsigned* __restrict__ wmax, signed char* __restrict__ wq8, int nrows = 2048) {
    const float mxw = __uint_as_float(*(const volatile unsigned*)wmax);
    const float inv = mxw > 0.f ? 127.0f / mxw : 0.f;
    for (int n = cx.gwave; n < nrows; n += cx.nwave) {
        const uint4 r0 = *(const uint4*)(wt_pq + (size_t)n * 1024 + cx.lane * 16), r1 = *(const uint4*)(wt_pq + (size_t)n * 1024 + cx.lane * 16 + 8);
        float f[16]; unpack8(r0, f); unpack8(r1, f + 8);
        unsigned w[4] = {0u, 0u, 0u, 0u};
#pragma unroll
        for (int i = 0; i < 16; ++i) { int q8 = (int)rintf(f[i] * inv); q8 = q8 < -127 ? -127 : (q8 > 127 ? 127 : q8); w[i >> 2] |= ((unsigned)q8 & 0xFFu) << (8 * (i & 3)); }
        *(uint4*)(wq8 + (size_t)n * 1024 + cx.lane * 16) = make_uint4(w[0], w[1], w[2], w[3]);
    }
}
__device__ __forceinline__ void ph_h2(const Ctx& cx, const float* __restrict__ x, const bf16_t* __restrict__ mixb, const float* __restrict__ mod, const float* __restrict__ g2, float* __restrict__ out, bf16_t* __restrict__ h2,
                                      unsigned* __restrict__ hqn, float* __restrict__ hs) {
    for (int rb = cx.gwave * 4; rb < T; rb += cx.nwave * 4) {
        const float* src[4]; const float* md[4]; bf16_t* dst[4]; const bf16_t* mx[4]; float* xo[4]; unsigned* hq4[4]; float* hs4[4];
#pragma unroll
        for (int u = 0; u < 4; ++u) { const int r = rb + u; src[u] = x + (size_t)r * D; md[u] = mod + (r / S) * 6144; dst[u] = (bf16_t*)((unsigned char*)h2 + (size_t)r * D); mx[u] = mixb + (size_t)r * D; xo[u] = out + (size_t)r * D;
            hq4[u] = hqn + (size_t)r * 256; hs4[u] = hs + r; }
        norm_mod_rows4<true>(cx.lane, src, md, 3 * D, 4 * D, g2, dst, mx, 2 * D, xo, hq4, hs4);
    }
}

namespace att {
using bf16x8 = __attribute__((ext_vector_type(8))) short;
using s16x4  = __attribute__((ext_vector_type(4))) short;
using f32x16 = __attribute__((ext_vector_type(16))) float;
using u32x4  = __attribute__((ext_vector_type(4))) unsigned;
constexpr int KROW = 208;
constexpr int SHM_V = 64 * 64 * 2, SHM_K = 64 * KROW, SHM_ATTN = 2 * SHM_V + 2 * SHM_K + 8 * 64 * 4;
constexpr float SCALE = 0.10206207261596577f;
constexpr float THR = 8.f;
constexpr int LDQ = 768, LDO = 1024;
#define ATT_SBAR() __builtin_amdgcn_sched_barrier(0)
__device__ __forceinline__ int crow(int r, int hi) { return (r & 3) + 8 * (r >> 2) + 4 * hi; }
__device__ __forceinline__ unsigned cvtpk(float lo, float hi) { unsigned r; asm volatile("v_cvt_pk_bf16_f32 %0, %1, %2" : "=v"(r) : "v"(lo), "v"(hi)); return r; }
constexpr float THR2 = 8.f * 1.4426950408889634f;
__device__ __forceinline__ void partialSM(f32x16& p0, f32x16& p1, float& thr, float& alpha, f32x16& negm) {
  float pmax = p0[0];
#pragma unroll
  for (int r = 1; r < 16; ++r) pmax = fmaxf(pmax, p0[r]);
#pragma unroll
  for (int r = 0; r < 16; ++r) pmax = fmaxf(pmax, p1[r]);
  { auto rr = __builtin_amdgcn_permlane32_swap(__float_as_uint(pmax), __float_as_uint(pmax), false, false);
    asm("v_max_f32 %0, %1, %2" : "=v"(pmax) : "v"(rr[0]), "v"(rr[1])); }
  if (__builtin_expect(__all(pmax <= thr), 1)) { alpha = 1.f; }
  else {
    const bool first = thr < 0.f;
    const float d = first ? pmax : fmaxf(pmax, 0.f);
    alpha = first ? 1.f : __builtin_amdgcn_exp2f(-d);
    thr = THR2;
#pragma unroll
    for (int r = 0; r < 16; ++r) { p0[r] -= d; p1[r] -= d; negm[r] -= d; }
  }
#pragma unroll
  for (int r = 0; r < 16; ++r) p0[r] = __builtin_amdgcn_exp2f(p0[r]);
}
__device__ __forceinline__ void finishSM(f32x16& p0, f32x16& p1, float alpha, float& l_reg, bf16x8& pa0, bf16x8& pa1, bf16x8& pa2, bf16x8& pa3) {
#pragma unroll
  for (int r = 0; r < 16; ++r) p1[r] = __builtin_amdgcn_exp2f(p1[r]);
  (void)alpha; (void)l_reg;
#define ATT_PK4(P, BASE, OUT) do { unsigned a0 = cvtpk(P[BASE + 0], P[BASE + 1]), a1 = cvtpk(P[BASE + 2], P[BASE + 3]);   \
    unsigned b0 = cvtpk(P[BASE + 4], P[BASE + 5]), b1 = cvtpk(P[BASE + 6], P[BASE + 7]);                              \
    auto r0 = __builtin_amdgcn_permlane32_swap(a0, b0, false, false); auto r1 = __builtin_amdgcn_permlane32_swap(a1, b1, false, false); \
    u32x4 w = {r0[0], r1[0], r0[1], r1[1]}; OUT = *reinterpret_cast<bf16x8*>(&w); } while (0)
  ATT_PK4(p0, 0, pa0); ATT_PK4(p0, 8, pa1); ATT_PK4(p1, 0, pa2); ATT_PK4(p1, 8, pa3);
#undef ATT_PK4
}
__device__ __forceinline__ void qkt(f32x16& p0, f32x16& p1, const char* Ks, const bf16x8* qr, int r32, int hi, const f32x16& negm) {
#pragma unroll
  for (int d0 = 0; d0 < 6; ++d0) { const int cb = (d0 * 16 + hi * 8) * 2;
    bf16x8 b0 = *reinterpret_cast<const bf16x8*>(Ks + r32 * KROW + cb);
    bf16x8 b1 = *reinterpret_cast<const bf16x8*>(Ks + (32 + r32) * KROW + cb);
    p0 = __builtin_amdgcn_mfma_f32_32x32x16_bf16(b0, qr[d0], d0 == 0 ? negm : p0, 0, 0, 0);
    p1 = __builtin_amdgcn_mfma_f32_32x32x16_bf16(b1, qr[d0], d0 == 0 ? negm : p1, 0, 0, 0); }
}
__device__ __forceinline__ int v_st(int k, int c) { const int kk = (k & ~0xC) | ((k & 4) << 1) | ((k & 8) >> 1); return ((kk >> 3) * 2 + (c >> 5)) * 512 + ((kk & 7) * 32 + (c & 31)) * 2; }
__device__ __forceinline__ int v_rd_base(int lane) { return ((lane & 3) << 3) | (((lane >> 2) & 3) << 6) | (((lane >> 4) & 1) << 5) | (((lane >> 5) & 1) << 8); }
constexpr int v_rd_off(int d0, int ks, int half) { return d0 * 512 + ks * 2048 + half * 1024; }
template <int OFF> __device__ __forceinline__ s16x4 tr_read(int vb) {
  s16x4 r; asm volatile("ds_read_b64_tr_b16 %0, %1 offset:%2" : "=&v"(r) : "v"(vb), "i"(OFF) : "memory"); return r;
}
template <int D0> __device__ __forceinline__ void pv_one(f32x16& od, int vb, bf16x8 pa0, bf16x8 pa1, bf16x8 pa2, bf16x8 pa3) {
  const s16x4 l0 = tr_read<v_rd_off(D0, 0, 0)>(vb), h0 = tr_read<v_rd_off(D0, 0, 1)>(vb), l1 = tr_read<v_rd_off(D0, 1, 0)>(vb), h1 = tr_read<v_rd_off(D0, 1, 1)>(vb);
  const s16x4 l2 = tr_read<v_rd_off(D0, 2, 0)>(vb), h2 = tr_read<v_rd_off(D0, 2, 1)>(vb), l3 = tr_read<v_rd_off(D0, 3, 0)>(vb), h3 = tr_read<v_rd_off(D0, 3, 1)>(vb);
  asm volatile("s_waitcnt lgkmcnt(0)" ::: "memory"); ATT_SBAR();
#define ATT_PK(L, H) (bf16x8){L[0], L[1], L[2], L[3], H[0], H[1], H[2], H[3]}
  od = __builtin_amdgcn_mfma_f32_32x32x16_bf16(pa0, ATT_PK(l0, h0), od, 0, 0, 0);
  od = __builtin_amdgcn_mfma_f32_32x32x16_bf16(pa1, ATT_PK(l1, h1), od, 0, 0, 0);
  od = __builtin_amdgcn_mfma_f32_32x32x16_bf16(pa2, ATT_PK(l2, h2), od, 0, 0, 0);
  od = __builtin_amdgcn_mfma_f32_32x32x16_bf16(pa3, ATT_PK(l3, h3), od, 0, 0, 0);
#undef ATT_PK
}
__device__ __forceinline__ void pv_d0(f32x16* o, int vb, bf16x8 pa0, bf16x8 pa1, bf16x8 pa2, bf16x8 pa3) {
  pv_one<0>(o[0], vb, pa0, pa1, pa2, pa3); pv_one<1>(o[1], vb, pa0, pa1, pa2, pa3);
  const bf16x8 ones = {0x3F80, 0x3F80, 0x3F80, 0x3F80, 0x3F80, 0x3F80, 0x3F80, 0x3F80};
  o[2] = __builtin_amdgcn_mfma_f32_32x32x16_bf16(pa0, ones, o[2], 0, 0, 0);
  o[2] = __builtin_amdgcn_mfma_f32_32x32x16_bf16(pa1, ones, o[2], 0, 0, 0);
  o[2] = __builtin_amdgcn_mfma_f32_32x32x16_bf16(pa2, ones, o[2], 0, 0, 0);
  o[2] = __builtin_amdgcn_mfma_f32_32x32x16_bf16(pa3, ones, o[2], 0, 0, 0);
}
__device__ __forceinline__ void attn_body(const bf16_t* __restrict__ Qb, const bf16_t* __restrict__ Kh, const bf16_t* __restrict__ Vh, bf16_t* __restrict__ Ob, int seq, char* lds,
                                          const float* __restrict__ gq, const float* __restrict__ rope, int s0) {
  int tid = threadIdx.x; asm volatile("" : "+v"(tid));
  const int wid = tid >> 6, lane = tid & 63, r32 = lane & 31, hi = lane >> 5;
  char* V_lds = lds; char* K_lds = lds + 2 * SHM_V;
  float* wsl = (float*)(lds + 2 * SHM_V + 2 * SHM_K) + wid * 64; float* li_l = wsl; float* al_l = wsl + 32;
  float thr = -INFINITY, l_reg = 0; f32x16 o[3] = {}; f32x16 negm = {}; bf16x8 qr[6];
  const bf16_t* Qw = Qb + (long)(wid * 32 + r32) * LDQ + hi * 8;
  const bool k1on = tid < 256;
  const int kc0 = tid, kc1 = 512 + tid;
  const int kst0 = (kc0 / 12) * KROW + (kc0 % 12) * 16, kst1 = (kc1 / 12) * KROW + (kc1 % 12) * 16;
  const int vst0 = v_st(tid >> 3, (tid & 7) * 8);
  const int vb0 = (int)(uintptr_t)V_lds + v_rd_base(lane);
  struct { bf16x8 vs0, ks0, ks1; } sr_[2];
#define ATT_SLOAD(i, k0) do { sr_[i].vs0 = *reinterpret_cast<const bf16x8*>(Vh + (long)(k0) * 64 + tid * 8); \
    sr_[i].ks0 = *reinterpret_cast<const bf16x8*>(Kh + (long)(k0) * 96 + kc0 * 8); \
    if (k1on) sr_[i].ks1 = *reinterpret_cast<const bf16x8*>(Kh + (long)(k0) * 96 + kc1 * 8); } while (0)
#define ATT_SWRITE(b, i) do { *(bf16x8*)(V_lds + (b) * SHM_V + vst0) = sr_[i].vs0; \
    *(bf16x8*)(K_lds + (b) * SHM_K + kst0) = sr_[i].ks0; \
    if (k1on) *(bf16x8*)(K_lds + (b) * SHM_K + kst1) = sr_[i].ks1; } while (0)
#define ATT_SWAIT() asm volatile("s_waitcnt vmcnt(3)" ::: "memory")
#define ATT_RESC(a) do { if (__any((a) < 1.f)) { if (hi == 0) al_l[r32] = (a); asm volatile("s_waitcnt lgkmcnt(0)" ::: "memory"); \
    _Pragma("unroll") for (int d = 0; d < 3; ++d) _Pragma("unroll") for (int r = 0; r < 16; ++r) o[d][r] *= al_l[crow(r, hi)]; } } while (0)
  f32x16 pA0, pA1, pB0, pB1; float alA, alB; bf16x8 pa0, pa1, pa2, pa3; const int NT = seq / 64;
  constexpr int SE = 0, SO = 1;
  ATT_SLOAD(SE, 0);
  __builtin_amdgcn_sched_barrier(0);
  {
    uint4 raw[6]; float ss = 0.f;
    const int spos = s0 + wid * 32 + r32;
#pragma unroll
    for (int d0 = 0; d0 < 6; ++d0) raw[d0] = *reinterpret_cast<const uint4*>(Qw + d0 * 16);
    float4 gA[6], gB[6]; float2 cs4[8], cs5[8];
#pragma unroll
    for (int d0 = 0; d0 < 6; ++d0) { gA[d0] = *(const float4*)(gq + d0 * 16 + hi * 8); gB[d0] = *(const float4*)(gq + d0 * 16 + hi * 8 + 4); }
#pragma unroll
    for (int j = 0; j < 8; ++j) { cs4[j] = *(const float2*)(rope + ((spos >> 6) * 8 + j) * 2); cs5[j] = *(const float2*)(rope + ((spos & 63) * 8 + j) * 2); }
    __builtin_amdgcn_sched_barrier(0);
#pragma unroll
    for (int d0 = 0; d0 < 6; ++d0) { float t8[8]; unpack8(raw[d0], t8);
#pragma unroll
      for (int j = 0; j < 8; ++j) ss += t8[j] * t8[j]; }
    ss += __shfl_xor(ss, 32);
    const float rstd = rsqrtf(ss / 96.0f + EPS) * (SCALE * 1.4426950408889634f);
#pragma unroll
    for (int d0 = 0; d0 < 6; ++d0) {
      float t8[8]; unpack8(raw[d0], t8);
      const float4 g0 = gA[d0], g1 = gB[d0];
      t8[0] *= rstd * g0.x; t8[1] *= rstd * g0.y; t8[2] *= rstd * g0.z; t8[3] *= rstd * g0.w; t8[4] *= rstd * g1.x; t8[5] *= rstd * g1.y; t8[6] *= rstd * g1.z; t8[7] *= rstd * g1.w;
      if (d0 >= 4) {
#pragma unroll
        for (int j = 0; j < 8; ++j) {
          const float2 cs = (d0 == 5) ? cs5[j] : cs4[j];
          const float mine = t8[j], other = __shfl_xor(mine, 32);
          t8[j] = hi ? (mine * cs.x + other * cs.y) : (mine * cs.x - other * cs.y);
        }
      }
      const uint4 w = pack8(t8); qr[d0] = *reinterpret_cast<const bf16x8*>(&w);
      __builtin_amdgcn_sched_barrier(0);
    }
  }
  __syncthreads();
  asm volatile("s_waitcnt vmcnt(0)" ::: "memory"); ATT_SWRITE(0, SE); __syncthreads();
  qkt(pA0, pA1, K_lds, qr, r32, hi, negm); partialSM(pA0, pA1, thr, alA, negm);
  ATT_SLOAD(SO, 64); if (2 < NT) ATT_SLOAD(SE, 128);
  ATT_SWAIT(); ATT_SWRITE(1, SO); __syncthreads();
  for (int j = 1; j + 1 < NT; j += 2) {
    ATT_SBAR(); qkt(pB0, pB1, K_lds + SHM_K, qr, r32, hi, negm);
    finishSM(pA0, pA1, alA, l_reg, pa0, pa1, pa2, pa3); ATT_SBAR();
    ATT_SLOAD(SO, (j + 2) * 64); ATT_SBAR();
    pv_d0(o, vb0, pa0, pa1, pa2, pa3); partialSM(pB0, pB1, thr, alB, negm);
    __syncthreads(); ATT_SWAIT(); ATT_SWRITE(0, SE);
    ATT_RESC(alB); __syncthreads();
    ATT_SBAR(); qkt(pA0, pA1, K_lds, qr, r32, hi, negm);
    finishSM(pB0, pB1, alB, l_reg, pa0, pa1, pa2, pa3); ATT_SBAR();
    if (j + 3 < NT) ATT_SLOAD(SE, (j + 3) * 64); ATT_SBAR();
    pv_d0(o, vb0 + SHM_V, pa0, pa1, pa2, pa3); partialSM(pA0, pA1, thr, alA, negm);
    __syncthreads(); if (j + 3 < NT) { ATT_SWAIT(); } else { asm volatile("s_waitcnt vmcnt(0)" ::: "memory"); }
    ATT_SWRITE(1, SO);
    ATT_RESC(alA); __syncthreads();
  }
  ATT_SBAR(); qkt(pB0, pB1, K_lds + SHM_K, qr, r32, hi, negm);
  finishSM(pA0, pA1, alA, l_reg, pa0, pa1, pa2, pa3); ATT_SBAR();
  pv_d0(o, vb0, pa0, pa1, pa2, pa3); partialSM(pB0, pB1, thr, alB, negm);
  __syncthreads(); ATT_RESC(alB);
  finishSM(pB0, pB1, alB, l_reg, pa0, pa1, pa2, pa3); ATT_SBAR();
  pv_d0(o, vb0 + SHM_V, pa0, pa1, pa2, pa3);
  (void)li_l;
  float rli[16];
#pragma unroll
  for (int r = 0; r < 16; ++r) rli[r] = __builtin_amdgcn_rcpf(o[2][r]);
  bf16_t* Ow = Ob + (long)(wid * 32) * LDO;
#pragma unroll
  for (int r = 0; r < 16; ++r) { const int orow = crow(r, hi);
#pragma unroll
    for (int d0 = 0; d0 < 2; ++d0) Ow[(long)orow * LDO + d0 * 32 + r32] = f2bf(o[d0][r] * rli[r]); }
#undef ATT_SLOAD
#undef ATT_SWRITE
#undef ATT_SWAIT
#undef ATT_RESC
}
}

__device__ __forceinline__ void ph_attn_mfma(char* lds, const bf16_t* __restrict__ Q, const bf16_t* __restrict__ Kb, const bf16_t* __restrict__ Vb, bf16_t* __restrict__ mixin,
                                             const float* __restrict__ g_qk_q, const float* __restrict__ rope) {
    for (int unit = blockIdx.x; unit < NB * NH * 8; unit += gridDim.x) {
        const int xcd = unit & 7, slot = (unit >> 3) & 31, jj = unit >> 8;
        const int bh = xcd + 8 * ((slot >> 3) + 4 * jj), qblk = slot & 7, b = bh >> 3, h = bh & 7;
        att::attn_body(Q + ((size_t)(b * S + qblk * 256) * NH + h) * 96, Kb + (size_t)bh * SKV * 96, Vb + (size_t)bh * SKV * 64,
                       mixin + (size_t)(b * S + qblk * 256) * 1024 + 512 + h * 64, SKV, lds, g_qk_q, rope, qblk * 256);
    }
}


typedef float f32x2_t __attribute__((ext_vector_type(2)));


__device__ __forceinline__ void cvt8n_row(int lane, int r, const float4 (&v)[4], unsigned char* __restrict__ u4, unsigned char* __restrict__ v8, float* __restrict__ su) {
    const bool isu = r < 16384; const int rr = isu ? r : r - 16384;
    float mx = 0.f;
#pragma unroll
    for (int i = 0; i < 4; ++i) mx = fmaxf(mx, fmaxf(fmaxf(fabsf(v[i].x), fabsf(v[i].y)), fmaxf(fabsf(v[i].z), fabsf(v[i].w))));
    mx = wave_max(mx);
    if (isu) {
        const float s = mx > 0.f ? mx * 0.1f : 1.0f, inv = 1.0f / s;
        unsigned w0 = 0u, w1 = 0u;
        const float xs[16] = {v[0].x, v[0].y, v[0].z, v[0].w, v[1].x, v[1].y, v[1].z, v[1].w, v[2].x, v[2].y, v[2].z, v[2].w, v[3].x, v[3].y, v[3].z, v[3].w};
#pragma unroll
        for (int k = 0; k < 8; ++k) {
            int q0 = (int)rintf(xs[k] * inv), q1 = (int)rintf(xs[8 + k] * inv);
            q0 = q0 < -8 ? -8 : (q0 > 7 ? 7 : q0); q1 = q1 < -8 ? -8 : (q1 > 7 ? 7 : q1);
            w0 |= ((unsigned)q0 & 0xFu) << (4 * k); w1 |= ((unsigned)q1 & 0xFu) << (4 * k);
        }
        *(uint2*)(u4 + (size_t)(lane >> 4) * (16384 * 128) + (size_t)rr * 128 + (lane & 15) * 8) = make_uint2(w0, w1);
        if (lane == 0) su[2 * rr] = s;
    } else {
        const float s = mx > 0.f ? mx * (0.85f / 6.0f) : 1.0f, inv = 1.0f / s;
        unsigned w0 = 0u, w1 = 0u;
        w0 = __builtin_amdgcn_cvt_scalef32_pk_fp4_f32(w0, v[0].x * inv, v[0].y * inv, 1.0f, 0); w0 = __builtin_amdgcn_cvt_scalef32_pk_fp4_f32(w0, v[0].z * inv, v[0].w * inv, 1.0f, 1);
        w0 = __builtin_amdgcn_cvt_scalef32_pk_fp4_f32(w0, v[1].x * inv, v[1].y * inv, 1.0f, 2); w0 = __builtin_amdgcn_cvt_scalef32_pk_fp4_f32(w0, v[1].z * inv, v[1].w * inv, 1.0f, 3);
        w1 = __builtin_amdgcn_cvt_scalef32_pk_fp4_f32(w1, v[2].x * inv, v[2].y * inv, 1.0f, 0); w1 = __builtin_amdgcn_cvt_scalef32_pk_fp4_f32(w1, v[2].z * inv, v[2].w * inv, 1.0f, 1);
        w1 = __builtin_amdgcn_cvt_scalef32_pk_fp4_f32(w1, v[3].x * inv, v[3].y * inv, 1.0f, 2); w1 = __builtin_amdgcn_cvt_scalef32_pk_fp4_f32(w1, v[3].z * inv, v[3].w * inv, 1.0f, 3);
        *(uint2*)(v8 + (size_t)(lane >> 4) * (16384 * 128) + (size_t)rr * 128 + (lane & 15) * 8) = make_uint2(w0, w1);
        if (lane == 0) su[2 * rr + 1] = s;
    }
}
__device__ __forceinline__ void ph_cvt8n(const Ctx& cx, const float* __restrict__ pu, const float* __restrict__ pv, unsigned char* __restrict__ u4, unsigned char* __restrict__ v8,
                                         float* __restrict__ su, float* __restrict__ sv, int r0 = 0, int r1 = 2 * 16384) {
    (void)sv;
    for (int r = r0 + cx.gwave; r < r1; r += 2 * cx.nwave) {
        const int rb = r + cx.nwave; const bool hasB = rb < r1; const int rbc = hasB ? rb : r;
        const float* sa = (r < 16384 ? pu + (size_t)r * D : pv + (size_t)(r - 16384) * D) + cx.lane * 16;
        const float* sb = (rbc < 16384 ? pu + (size_t)rbc * D : pv + (size_t)(rbc - 16384) * D) + cx.lane * 16;
        float4 va[4], vb[4];
#pragma unroll
        for (int i = 0; i < 4; ++i) { va[i] = *(const float4*)(sa + i * 4); vb[i] = *(const float4*)(sb + i * 4); }
        cvt8n_row(cx.lane, r, va, u4, v8, su);
        if (hasB) cvt8n_row(cx.lane, rb, vb, u4, v8, su);
    }
}
#define LDI(ptr, idx) (*(const int*)((const char*)(ptr) + (unsigned)((idx) * 4)))
#define LDF(ptr, idx) (*(const float*)((const char*)(ptr) + (unsigned)((idx) * 4)))
#define LDU4(ptr, byteoff) (*(const uint4*)((const char*)(ptr) + (unsigned)(byteoff)))
__device__ __forceinline__ void ph_peer_u(const Ctx& cx, int rk, int nloc, int ti, int nteam, const unsigned* __restrict__ hqn, const float* __restrict__ hs, const int* __restrict__ eidx, const unsigned char* __restrict__ u4, float* __restrict__ pa) {
    const int lane = cx.lane, p = lane >> 3, q = lane & 7;
    for (int item = ti; item < 8; item += nteam) {
        const int c = item & 3, hf = item >> 2;
        const int ts = nloc * 16, tb = 2 * (rk * 8 + cx.wib) + hf;
        const int n = tb < T ? (T - 1 - tb) / ts + 1 : 0;
        if (n == 0) continue;
        const int tlast = tb + (n - 1) * ts;
        const unsigned hoff = (unsigned)((c * 32 + q * 4) * 4);
        const unsigned toff = (unsigned)(c * (16384 * 128) + q * 16);
        uint4 rowsA[16], rowsB[16];
        const int t0 = tb, t1 = n > 1 ? tb + ts : tlast, t2p = n > 2 ? tb + 2 * ts : tlast;
        uint4 hhc = LDU4(hqn, t0 * 1024 + (int)hoff), hlc = LDU4(hqn, t0 * 1024 + 512 + (int)hoff); float shc = LDF(hs, t0);
        uint4 hhn = LDU4(hqn, t1 * 1024 + (int)hoff), hln = LDU4(hqn, t1 * 1024 + 512 + (int)hoff); float shn = LDF(hs, t1);
        int idn;
        const unsigned sh16 = (unsigned)(p & 1) * 16u;
        { const int idc = LDI(eidx, t0 * 64 + lane);
          idn = LDI(eidx, t1 * 64 + lane);
#pragma unroll
          for (int r = 0; r < 16; ++r) { const unsigned id = __builtin_amdgcn_ubfe((unsigned)__builtin_amdgcn_ds_bpermute((4 * r + (p >> 1)) << 2, idc), sh16, 16u); rowsA[r] = *(const uint4*)(u4 + (id * 128u + toff)); } }
        asm volatile("" : "+v"(idn), "+v"(shc), "+v"(shn));
        asm volatile("" : "+v"(hhc.x), "+v"(hhc.y), "+v"(hhc.z), "+v"(hhc.w), "+v"(hlc.x), "+v"(hlc.y), "+v"(hlc.z), "+v"(hlc.w), "+v"(hhn.x), "+v"(hhn.y), "+v"(hhn.z), "+v"(hhn.w), "+v"(hln.x), "+v"(hln.y), "+v"(hln.z), "+v"(hln.w));
#pragma unroll
        for (int r = 0; r < 16; ++r) asm volatile("" : "+v"(rowsA[r].x), "+v"(rowsA[r].y), "+v"(rowsA[r].z), "+v"(rowsA[r].w));
        (void)t2p;
        auto step = [&](uint4 (&cur)[16], uint4 (&nxt)[16], const int i) __attribute__((always_inline)) {
            const int tcur = (i < n) ? tb + i * ts : tlast;
            const int t2 = (i + 2 < n) ? tb + (i + 2) * ts : tlast;
            const int idf = LDI(eidx, t2 * 64 + lane);
            const uint4 hhf = LDU4(hqn, t2 * 1024 + (int)hoff), hlf4 = LDU4(hqn, t2 * 1024 + 512 + (int)hoff); const float shf = LDF(hs, t2);
#pragma unroll
            for (int r = 0; r < 16; ++r) { const unsigned ro = __builtin_amdgcn_ubfe((unsigned)__builtin_amdgcn_ds_bpermute((4 * r + (p >> 1)) << 2, idn), sh16, 16u) * 128u + toff; nxt[r] = *(const uint4*)(u4 + ro); }
            __builtin_amdgcn_sched_barrier(0);
            float o0 = 0.f, o1 = 0.f;
#pragma unroll
            for (int r = 0; r < 16; ++r) {
                int ah = 0, al = 0;
                ah = __builtin_amdgcn_sdot8((int)cur[r].x, (int)hhc.x, ah, false); al = __builtin_amdgcn_sdot8((int)cur[r].x, (int)hlc.x, al, false);
                ah = __builtin_amdgcn_sdot8((int)cur[r].y, (int)hhc.y, ah, false); al = __builtin_amdgcn_sdot8((int)cur[r].y, (int)hlc.y, al, false);
                ah = __builtin_amdgcn_sdot8((int)cur[r].z, (int)hhc.z, ah, false); al = __builtin_amdgcn_sdot8((int)cur[r].z, (int)hlc.z, al, false);
                ah = __builtin_amdgcn_sdot8((int)cur[r].w, (int)hhc.w, ah, false); al = __builtin_amdgcn_sdot8((int)cur[r].w, (int)hlc.w, al, false);
                const float d = sum8_dpp((float)(ah * 16 + al));
                if (q == (r & 7)) { if (r < 8) o0 = d; else o1 = d; }
            }
            *(bf16_t*)((char*)pa + (size_t)c * T * 256 + (unsigned)((tcur * 128 + q * 8 + p) * 2)) = f2bf(o0 * shc);
            *(bf16_t*)((char*)pa + (size_t)c * T * 256 + (unsigned)((tcur * 128 + 64 + q * 8 + p) * 2)) = f2bf(o1 * shc);
            idn = idf; hhc = hhn; hlc = hln; shc = shn; hhn = hhf; hln = hlf4; shn = shf;
        };
        for (int i2 = 0; i2 < n; i2 += 2) { step(rowsA, rowsB, i2); step(rowsB, rowsA, i2 + 1); }
    }
}
typedef float f32x2q_t __attribute__((ext_vector_type(2)));
struct R4In { uint4 e; uint4 p[4]; uint4 g; };
__device__ __forceinline__ void r4_load(R4In& in, int it8, const float* __restrict__ pa, const int* __restrict__ eidx, const float* __restrict__ gates) {
    const int base = it8 * 8;
    in.e = *(const uint4*)((const char*)eidx + (size_t)base * 2);
#pragma unroll
    for (int x = 0; x < 4; ++x) in.p[x] = *(const uint4*)((const char*)pa + (size_t)x * T * 256 + (size_t)base * 2);
    in.g = *(const uint4*)((const char*)gates + (size_t)base * 2);
}
__device__ __forceinline__ void r4_scales(const R4In& in, const float* ssv, float2 (&sc)[8]) {
    const int ee[8] = {(int)(in.e.x & 0xffffu), (int)(in.e.x >> 16), (int)(in.e.y & 0xffffu), (int)(in.e.y >> 16), (int)(in.e.z & 0xffffu), (int)(in.e.z >> 16), (int)(in.e.w & 0xffffu), (int)(in.e.w >> 16)};
#pragma unroll
    for (int k = 0; k < 8; ++k) sc[k] = *(const float2*)(ssv + 2 * ee[k]);
}
__device__ __forceinline__ void r4_finish(const R4In& in, const float2 (&sc)[8], int it8, unsigned* __restrict__ abuf, float* __restrict__ s0buf) {
    float aa[8] = {0.f, 0.f, 0.f, 0.f, 0.f, 0.f, 0.f, 0.f};
#pragma unroll
    for (int x = 0; x < 4; ++x) { float f8[8]; unpack8(in.p[x], f8);
#pragma unroll
        for (int k = 0; k < 8; ++k) aa[k] += f8[k]; }
    float gg[8]; unpack8(in.g, gg);
    float cc[8]; float mx = 0.f;
#pragma unroll
    for (int k = 0; k < 8; ++k) { const float a = aa[k] * sc[k].x; const float act = 0.5f * a * (1.0f + erff(a * 0.70710678118654752f)); cc[k] = gg[k] * act * sc[k].y; mx = fmaxf(mx, fabsf(cc[k])); }
    mx = fmaxf(mx, __shfl_xor(mx, 1)); mx = fmaxf(mx, __shfl_xor(mx, 2)); mx = fmaxf(mx, __shfl_xor(mx, 4)); mx = fmaxf(mx, __shfl_xor(mx, 8));
    const float s0 = mx > 0.f ? mx * (1.0f / 6.0f) : 1.0f, inv = 1.0f / s0;
    unsigned w[4] = {0u, 0u, 0u, 0u};
#define R4_PAIR(PR) do { float ra = cc[2 * (PR)] * inv, rb = cc[2 * (PR) + 1] * inv; \
        _Pragma("unroll") for (int tI = 0; tI < 4; ++tI) { \
            w[tI] = __builtin_amdgcn_cvt_scalef32_pk_fp4_f32(w[tI], ra, rb, 1.0f, PR); \
            const f32x2q_t d = __builtin_amdgcn_cvt_scalef32_pk_f32_fp4(w[tI], 1.0f, PR); \
            ra = (ra - d[0]) * 4.0f; rb = (rb - d[1]) * 4.0f; } } while (0)
    R4_PAIR(0); R4_PAIR(1); R4_PAIR(2); R4_PAIR(3);
#undef R4_PAIR
    const int t = it8 >> 4, j8 = it8 & 15;
#pragma unroll
    for (int tI = 0; tI < 4; ++tI) abuf[(t * 4 + tI) * 16 + j8] = w[tI];
    if (j8 == 0) s0buf[t] = s0;
}
__device__ __forceinline__ void ph_peer_r4(const Ctx& cx, char* lds, const float* __restrict__ pa, const int* __restrict__ eidx, const float* __restrict__ gates, const float* __restrict__ ssv_g,
                                           unsigned* __restrict__ abuf, float* __restrict__ s0buf) {
    __syncthreads();
    {
        float4 st[16];
#pragma unroll
        for (int i = 0; i < 16; ++i) st[i] = *(const float4*)(ssv_g + (cx.tid + i * NTHR) * 4);
#pragma unroll
        for (int i = 0; i < 16; ++i) *(float4*)(lds + (cx.tid + i * NTHR) * 16) = st[i];
    }
    __syncthreads();
    const float* ssv = (const float*)lds;
    for (int it8 = cx.gthr; it8 < T * 16; it8 += 2 * cx.nthr) {
        const int itB = it8 + cx.nthr; const bool hasB = itB < T * 16;
        R4In A, B; float2 sA[8], sB[8];
        r4_load(A, it8, pa, eidx, gates); r4_load(B, hasB ? itB : it8, pa, eidx, gates);
        r4_scales(A, ssv, sA); r4_scales(B, ssv, sB);
        r4_finish(A, sA, it8, abuf, s0buf);
        if (hasB) r4_finish(B, sB, itB, abuf, s0buf);
    }
    __syncthreads();
}
template <int OFF> __device__ __forceinline__ uint2 tr4_read(int vb) { uint2 r; asm volatile("ds_read_b64_tr_b4 %0, %1 offset:%2" : "=&v"(r) : "v"(vb), "i"(OFF) : "memory"); return r; }
typedef int i32x8v_t __attribute__((ext_vector_type(8)));
typedef float f32x4v_t __attribute__((ext_vector_type(4)));
__device__ __forceinline__ void ph_peer_v4(const Ctx& cx, char* lds, int rk, int nloc, int ti, int nteam, const int* __restrict__ eidx, const unsigned* __restrict__ abuf, const float* __restrict__ s0buf,
                                           const unsigned char* __restrict__ v4, const float* __restrict__ mod, const float* __restrict__ xin, const bf16_t* __restrict__ mixb, float* __restrict__ out) {
    const int lane = cx.lane, p = lane >> 3, q = lane & 7;
    const int m = lane & 15, g = lane >> 4, grp = m >> 2;
    char* wl = lds + cx.wib * 16384;
    float* ybuf = (float*)(lds + 131072 + cx.wib * 1024);
    const int rb = (int)(uintptr_t)wl + (32 * g + m) * 128, xs = m >> 1;
    const int wo_e = p * 128 + ((q ^ (p >> 1)) << 4), wo_o = p * 128 + ((q ^ (4 + (p >> 1))) << 4);
    const unsigned aoff = (unsigned)(((m & 3) * 16 + g * 4) * 4);
    for (int item = ti; item < 8; item += nteam) {
        const int c = item & 3, hf = item >> 2;
        const int ts = nloc * 16, tb = 2 * (rk * 8 + cx.wib) + hf;
        const int n = tb < T ? (T - 1 - tb) / ts + 1 : 0;
        if (n == 0) continue;
        const int tlast = tb + (n - 1) * ts;
        const unsigned toff = (unsigned)(c * (16384 * 128) + q * 16);
        const int col = c * 256 + lane * 4;
        uint4 rows[16];
        const int t0 = tb, t1 = n > 1 ? tb + ts : tlast;
        const unsigned sh16 = (unsigned)(p & 1) * 16u;
        int idc = LDI(eidx, t0 * 64 + lane);
        uint4 Ac = LDU4(abuf, t0 * 256 + (int)aoff); float s0c = LDF(s0buf, t0);
        int idn = LDI(eidx, t1 * 64 + lane);
        uint4 An = LDU4(abuf, t1 * 256 + (int)aoff); float s0n = LDF(s0buf, t1);
#pragma unroll
        for (int r = 0; r < 16; ++r) { const unsigned id = __builtin_amdgcn_ubfe((unsigned)__builtin_amdgcn_ds_bpermute((4 * r + (p >> 1)) << 2, idc), sh16, 16u); rows[r] = *(const uint4*)(v4 + (id * 128u + toff)); }
        f32x4v_t gvc = f32x4v_t{0.f, 0.f, 0.f, 0.f}; int bprev = -1;
        for (int i = 0; i < n; ++i) {
            const int tcur = tb + i * ts;
            const int t2 = (i + 2 < n) ? tb + (i + 2) * ts : tlast;
            const int idf = LDI(eidx, t2 * 64 + lane);
            const uint4 Af = LDU4(abuf, t2 * 256 + (int)aoff); const float s0f = LDF(s0buf, t2);
            f32x2q_t mwf;
            { const int bcur = __builtin_amdgcn_readfirstlane(tcur / S); const unsigned om = (unsigned)((tcur * D + col) * 2);
              if (bcur != bprev) {
                  const unsigned og = (unsigned)((bcur * 6144 + 5 * D + col) * 4);
                  asm volatile("global_load_dwordx4 %0, %1, %2" : "=v"(gvc) : "v"(og), "s"(mod) : "memory");
                  bprev = bcur;
              }
              asm volatile("global_load_dwordx2 %0, %1, %2" : "=v"(mwf) : "v"(om), "s"(mixb) : "memory"); }
            unsigned roffs[16];
#pragma unroll
            for (int r = 0; r < 16; ++r) roffs[r] = __builtin_amdgcn_ubfe((unsigned)__builtin_amdgcn_ds_bpermute((4 * r + (p >> 1)) << 2, idn), sh16, 16u) * 128u + toff;
            __builtin_amdgcn_sched_barrier(0);
#pragma unroll
            for (int r = 0; r < 16; ++r) {
                { const uint4 w = rows[r]; *(uint4*)(wl + r * 1024 + ((r & 1) ? wo_o : wo_e)) = make_uint4(w.x, w.y, w.z, w.w); }
                __builtin_amdgcn_sched_barrier(0);
                rows[r] = *(const uint4*)(v4 + roffs[r]);
                __builtin_amdgcn_sched_barrier(0);
            }
#define V4_AG(G) (i32x8v_t{grp == (G) ? (int)Ac.x : 0, grp == (G) ? (int)Ac.y : 0, grp == (G) ? (int)Ac.z : 0, grp == (G) ? (int)Ac.w : 0, 0, 0, 0, 0})
            f32x4v_t acc[4];
#pragma unroll
            for (int k = 0; k < 4; ++k) acc[k] = f32x4v_t{0.f, 0.f, 0.f, 0.f};
#define V4_VQ(QD) (rb + (((QD) ^ xs) << 4))
#define V4_RD(NB, W) tr4_read<(W) * 2048 + ((NB) & 1) * 8>(V4_VQ((NB) >> 1))
            uint2 bl[16], bh[16];
#define V4_LD(NB) do { bl[NB] = V4_RD(NB, 0); bh[NB] = V4_RD(NB, 1); } while (0)
            V4_LD(0); V4_LD(1); V4_LD(2); V4_LD(3); V4_LD(4); V4_LD(5); V4_LD(6); V4_LD(7); V4_LD(8); V4_LD(9); V4_LD(10); V4_LD(11); V4_LD(12); V4_LD(13); V4_LD(14); V4_LD(15);
#undef V4_LD
            asm volatile("s_waitcnt lgkmcnt(0)" ::: "memory"); __builtin_amdgcn_sched_barrier(0);
#pragma unroll
            for (int g4 = 0; g4 < 4; ++g4)
#pragma unroll
                for (int k4 = 0; k4 < 4; ++k4) { const int nb = 4 * k4 + g4;
                    acc[k4] = __builtin_amdgcn_mfma_scale_f32_16x16x128_f8f6f4(V4_AG(g4), (i32x8v_t{(int)bl[nb].x, (int)bl[nb].y, (int)bh[nb].x, (int)bh[nb].y, 0, 0, 0, 0}), acc[k4], 4, 4, 0, 0x7F7F7F7F, 0, 0x7F7F7F7F); }
#undef V4_RD
#undef V4_VQ
#undef V4_AG
#pragma unroll
            for (int k = 0; k < 4; ++k) ybuf[64 * k + lane] = s0c * (acc[k][0] + 0.25f * acc[k][1] + 0.0625f * acc[k][2] + 0.015625f * acc[k][3]);
            const float4 yv = *(const float4*)(ybuf + 4 * lane);
            asm volatile("s_waitcnt vmcnt(16)" : "+v"(gvc), "+v"(mwf) :: "memory");
            const unsigned mw0 = __float_as_uint(mwf[0]), mw1 = __float_as_uint(mwf[1]);
            float4 ov = make_float4(__uint_as_float(mw0 << 16), __uint_as_float(mw0 & 0xffff0000u), __uint_as_float(mw1 << 16), __uint_as_float(mw1 & 0xffff0000u));
            ov.x += gvc[0] * yv.x; ov.y += gvc[1] * yv.y; ov.z += gvc[2] * yv.z; ov.w += gvc[3] * yv.w;
            *(float4*)((char*)out + (unsigned)((tcur * D + col) * 4)) = ov;
            idn = idf; Ac = An; An = Af; s0c = s0n; s0n = s0f;
        }
    }
}

namespace tk {
using bf16x8 = __attribute__((ext_vector_type(8))) short;
using f32x16 = __attribute__((ext_vector_type(16))) float;
constexpr int SKROW = 272;
constexpr int SK_BYTES = 2 * 128 * SKROW;
constexpr int IDX_OFF = SK_BYTES;
__device__ __forceinline__ void ce_desc(float& a, float& b) {
    float hi, lo;
    asm("v_max_f32 %0, %1, %2" : "=v"(hi) : "v"(a), "v"(b));
    asm("v_min_f32 %0, %1, %2" : "=v"(lo) : "v"(a), "v"(b));
    a = hi; b = lo;
}
__device__ __forceinline__ float fmax_raw(float a, float b) { float r; asm("v_max_f32 %0, %1, %2" : "=v"(r) : "v"(a), "v"(b)); return r; }
__device__ __forceinline__ void sort16(float (&k)[16]) {
#define CE(i, j) ce_desc(k[i], k[j])
    CE(0,1); CE(2,3); CE(0,2); CE(1,3); CE(1,2); CE(4,5); CE(6,7); CE(4,6); CE(5,7); CE(5,6); CE(0,4); CE(2,6); CE(2,4); CE(1,5); CE(3,7); CE(3,5); CE(1,2); CE(3,4); CE(5,6); CE(8,9); CE(10,11); CE(8,10); CE(9,11); CE(9,10); CE(12,13); CE(14,15); CE(12,14); CE(13,15); CE(13,14); CE(8,12); CE(10,14); CE(10,12); CE(9,13); CE(11,15); CE(11,13); CE(9,10); CE(11,12); CE(13,14); CE(0,8); CE(4,12); CE(4,8); CE(2,10); CE(6,14); CE(6,10); CE(2,4); CE(6,8); CE(10,12); CE(1,9); CE(5,13); CE(5,9); CE(3,11); CE(7,15); CE(7,11); CE(3,5); CE(7,9); CE(11,13); CE(1,2); CE(3,4); CE(5,6); CE(7,8); CE(9,10); CE(11,12); CE(13,14);
#undef CE
}
__device__ __forceinline__ void bmerge16(float (&k)[16]) {
#pragma unroll
    for (int j = 8; j > 0; j >>= 1)
#pragma unroll
        for (int i = 0; i < 16; ++i) { const int l = i ^ j; if (l > i) ce_desc(k[i], k[l]); }
}
__device__ __forceinline__ void merge_top16(float (&a)[16], const float (&b)[16]) {
#pragma unroll
    for (int i = 0; i < 16; ++i) a[i] = fmax_raw(a[i], b[15 - i]);
    bmerge16(a);
}
__device__ __forceinline__ void tk_loadq(bf16x8 (&qf)[8], const bf16_t* __restrict__ qrow, int p, int hi) {
#pragma unroll
    for (int ks = 0; ks < 8; ++ks) qf[ks] = *reinterpret_cast<const bf16x8*>(qrow + p * 128 + ks * 16 + hi * 8);
}
#define TK_SCORE(BLK, ACC, QF, P) do { ACC = f32x16{}; const char* arow_ = sk_lds + ((P) * 128 + (BLK) * 32 + r32) * SKROW + hi * 16; \
        _Pragma("unroll") for (int ks = 0; ks < 8; ++ks) { const bf16x8 af = *reinterpret_cast<const bf16x8*>(arow_ + ks * 32); ACC = __builtin_amdgcn_mfma_f32_32x32x16_bf16(af, (QF)[ks], ACC, 0, 0, 0); } } while (0)
__device__ __forceinline__ void tk_score0(const char* sk_lds, const bf16x8 (&qf)[8], int p, int r32, int hi, f32x16& acc0) { TK_SCORE(0, acc0, qf, p); }
__device__ __forceinline__ void half_top16(const char* sk_lds, const bf16x8 (&qf)[8], int p, int r32, int hi, float (&top)[16], f32x16& acc0, const bf16x8 (&qfn)[8], int pn) {
    float grp[4][16];
    f32x16 accn = acc0;
#pragma unroll
    for (int blk = 0; blk < 4; ++blk) {
        const f32x16 acc = accn;
        if (blk < 3) TK_SCORE(blk + 1, accn, qf, p); else TK_SCORE(0, acc0, qfn, pn);
#pragma unroll
        for (int r = 0; r < 16; ++r) { const int base = blk * 32 + (r & 3) + 8 * (r >> 2); grp[blk][r] = __uint_as_float((__float_as_uint(acc[r]) & ~0x7Fu) | (unsigned)(127 - base)); }
        sort16(grp[blk]);
    }
    merge_top16(grp[0], grp[1]); merge_top16(grp[2], grp[3]); merge_top16(grp[0], grp[2]);
    const unsigned hx = (unsigned)hi << 2;
    float mine[16], other[16];
#pragma unroll
    for (int i = 0; i < 16; ++i) { mine[i] = __uint_as_float(__float_as_uint(grp[0][i]) ^ hx); other[i] = __shfl_xor(mine[i], 32); }
    merge_top16(mine, other);
#pragma unroll
    for (int i = 0; i < 16; ++i) top[i] = mine[i];
}
__device__ __forceinline__ float cand(const float (&v1)[16], const float (&v2)[16], int a, int b) {
    return __uint_as_float((__float_as_uint(v1[a] + v2[b]) & ~0xFFu) | (unsigned)(255 - (a * 16 + b)));
}
__device__ __forceinline__ void ph_topk_mfma(const Ctx& cx, char* lds, const bf16_t* __restrict__ qp, const float* __restrict__ sub_keys, int* __restrict__ eidx, float* __restrict__ gates,
                                             const unsigned* __restrict__ wmax, const float* __restrict__ hs) {
    const float KS = __uint_as_float(*(const volatile unsigned*)wmax) * (1.0f / 127.0f);
    __syncthreads();
    {
        float4 f0[8], f1[8];
#pragma unroll
        for (int i = 0; i < 8; ++i) { const int e = cx.tid + i * NTHR, row = e >> 4, c8 = (e & 15) * 8;
            f0[i] = *(const float4*)(sub_keys + (size_t)row * 128 + c8); f1[i] = *(const float4*)(sub_keys + (size_t)row * 128 + c8 + 4); }
#pragma unroll
        for (int i = 0; i < 8; ++i) { const int e = cx.tid + i * NTHR, row = e >> 4, c8 = (e & 15) * 8;
            uint4 w; w.x = (unsigned)f2bf(f0[i].x * KS) | ((unsigned)f2bf(f0[i].y * KS) << 16); w.y = (unsigned)f2bf(f0[i].z * KS) | ((unsigned)f2bf(f0[i].w * KS) << 16);
            w.z = (unsigned)f2bf(f1[i].x * KS) | ((unsigned)f2bf(f1[i].y * KS) << 16); w.w = (unsigned)f2bf(f1[i].z * KS) | ((unsigned)f2bf(f1[i].w * KS) << 16);
            *(uint4*)(lds + row * SKROW + c8 * 2) = w; }
    }
    __syncthreads();
    const int r32 = cx.lane & 31, hi = cx.lane >> 5;
    unsigned char* itab = (unsigned char*)(lds + IDX_OFF + cx.tid * 32);
    bf16x8 q0[8], q1[8];
    f32x16 acc0 = {};
    if (cx.gwave < (T / 32) * 4) { const bf16_t* qr0 = qp + (size_t)((cx.gwave >> 2) * 32 + r32) * 2048 + (cx.gwave & 3) * 512; tk_loadq(q0, qr0, 0, hi); tk_loadq(q1, qr0, 1, hi); tk_score0(lds, q0, 0, r32, hi, acc0); }
    for (int unit = cx.gwave; unit < (T / 32) * 4; unit += cx.nwave) {
        const int tb = unit >> 2, hp = unit & 3, t = tb * 32 + r32, h = 2 * hp + hi;
        const bf16_t* qrow = qp + (size_t)t * 2048 + hp * 512;
        const int un = unit + cx.nwave < (T / 32) * 4 ? unit + cx.nwave : unit;
        const bf16_t* qrown = qp + (size_t)((un >> 2) * 32 + r32) * 2048 + (un & 3) * 512;
        const float hst = hs[t];
        float k1[16], k2[16];
        {   float a1[16], a2[16], b1[16], b2[16];
            half_top16(lds, q0, 0, r32, hi, a1, acc0, q1, 1);
            __builtin_amdgcn_sched_barrier(0);
            tk_loadq(q0, qrow + 256, 0, hi);
            __builtin_amdgcn_sched_barrier(0);
            half_top16(lds, q1, 1, r32, hi, a2, acc0, q0, 0);
            __builtin_amdgcn_sched_barrier(0);
            tk_loadq(q1, qrow + 256, 1, hi);
            __builtin_amdgcn_sched_barrier(0);
            half_top16(lds, q0, 0, r32, hi, b1, acc0, q1, 1);
            __builtin_amdgcn_sched_barrier(0);
            tk_loadq(q0, qrown, 0, hi);
            __builtin_amdgcn_sched_barrier(0);
            half_top16(lds, q1, 1, r32, hi, b2, acc0, q0, 0);
            __builtin_amdgcn_sched_barrier(0);
            tk_loadq(q1, qrown, 1, hi);
            __builtin_amdgcn_sched_barrier(0);
#pragma unroll
            for (int i = 0; i < 16; ++i) { k1[i] = hi ? b1[i] : a1[i]; k2[i] = hi ? b2[i] : a2[i]; }
        }
        float v1[16], v2[16];
        {
            unsigned nb[8];
#pragma unroll
            for (int i = 0; i < 8; ++i) nb[i] = 0u;
#pragma unroll
            for (int i = 0; i < 16; ++i) {
                const unsigned u1 = __float_as_uint(k1[i]), u2 = __float_as_uint(k2[i]);
                v1[i] = __uint_as_float(u1 & ~0x7Fu); v2[i] = __uint_as_float(u2 & ~0x7Fu);
                nb[i >> 2] |= (127u - (u1 & 0x7Fu)) << (8 * (i & 3)); nb[4 + (i >> 2)] |= (127u - (u2 & 0x7Fu)) << (8 * (i & 3));
            }
            *(uint4*)(itab) = make_uint4(nb[0], nb[1], nb[2], nb[3]); *(uint4*)(itab + 16) = make_uint4(nb[4], nb[5], nb[6], nb[7]);
        }
        float A[16], Bq[16], Cq[16], Dq[16];
#pragma unroll
        for (int b = 0; b < 16; ++b) A[b] = cand(v1, v2, 0, b);
#pragma unroll
        for (int b = 0; b < 8; ++b) Bq[b] = cand(v1, v2, 1, b);
#pragma unroll
        for (int i = 0; i < 8; ++i) Bq[8 + i] = cand(v1, v2, 15 - i, 0);
        bmerge16(Bq);
        __builtin_amdgcn_sched_barrier(0);
        merge_top16(A, Bq);
        __builtin_amdgcn_sched_barrier(0);
        Cq[0] = cand(v1, v2, 2, 0); Cq[1] = cand(v1, v2, 2, 1); Cq[2] = cand(v1, v2, 2, 2); Cq[3] = cand(v1, v2, 2, 3); Cq[4] = cand(v1, v2, 2, 4);
        Cq[5] = cand(v1, v2, 3, 0); Cq[6] = cand(v1, v2, 3, 1); Cq[7] = cand(v1, v2, 3, 2); Cq[8] = cand(v1, v2, 3, 3);
        Cq[9] = cand(v1, v2, 4, 0); Cq[10] = cand(v1, v2, 4, 1); Cq[11] = cand(v1, v2, 4, 2);
        Cq[12] = cand(v1, v2, 5, 0); Cq[13] = cand(v1, v2, 5, 1); Cq[14] = cand(v1, v2, 6, 0); Cq[15] = cand(v1, v2, 6, 1);
        sort16(Cq);
        __builtin_amdgcn_sched_barrier(0);
        Dq[0] = cand(v1, v2, 7, 0); Dq[1] = cand(v1, v2, 7, 1);
        ce_desc(Dq[0], Dq[1]);
#pragma unroll
        for (int i = 2; i < 16; ++i) Dq[i] = -INFINITY;
        merge_top16(Cq, Dq);
        __builtin_amdgcn_sched_barrier(0);
        merge_top16(A, Cq);
        int eo[16]; float tv[16]; float sum = 0.f;
#pragma unroll
        for (int i = 0; i < 16; ++i) {
            const unsigned u = __float_as_uint(A[i]); const unsigned pos = 255u - (u & 0xFFu);
            eo[i] = (int)itab[pos >> 4] * 128 + (int)itab[16 + (pos & 15)];
            tv[i] = __uint_as_float(u & ~0xFFu);
        }
        const float tmx = tv[0];
#pragma unroll
        for (int i = 0; i < 16; ++i) { tv[i] = __expf((tv[i] - tmx) * hst); sum += tv[i]; }
        const float inv = 1.0f / sum;
        {
            char* ep = (char*)eidx + ((size_t)t * 128 + h * 16) * 2;
#pragma unroll
            for (int i = 0; i < 2; ++i) *(uint4*)(ep + i * 16) = make_uint4((unsigned)eo[i * 8] | ((unsigned)eo[i * 8 + 1] << 16), (unsigned)eo[i * 8 + 2] | ((unsigned)eo[i * 8 + 3] << 16),
                                                                             (unsigned)eo[i * 8 + 4] | ((unsigned)eo[i * 8 + 5] << 16), (unsigned)eo[i * 8 + 6] | ((unsigned)eo[i * 8 + 7] << 16));
            char* gp = (char*)gates + ((size_t)t * 128 + h * 16) * 2;
#pragma unroll
            for (int i = 0; i < 16; ++i) tv[i] *= inv;
            *(uint4*)gp = pack8(tv); *(uint4*)(gp + 16) = pack8(tv + 8);
        }
    }
}
}


__device__ __forceinline__ void ph_fold(const Ctx& cx, char* lds, const float* __restrict__ pool_w, const float* __restrict__ pool_scale, const float* __restrict__ w_out, bf16_t* __restrict__ wt_out) {
    float (*P)[132] = (float (*)[132])lds;
    float (*Wn)[16] = (float (*)[16])(lds + 128 * 132 * 4);
    const int tid = cx.tid;
    for (int item = blockIdx.x; item < 4 * 64; item += gridDim.x) {
        const int g = item >> 6, nt = item & 63;
        __syncthreads();
#pragma unroll
        for (int i = 0; i < 8; ++i) {
            const int e = tid + 512 * i, c = e >> 5, j4 = (e & 31) * 4;
            const float4 pw = *(const float4*)(pool_w + ((size_t)g * 128 + c) * 128 + j4);
            const float4 ps = *(const float4*)(pool_scale + g * 128 + j4);
            *(float4*)&P[c][j4] = make_float4(pw.x * ps.x, pw.y * ps.y, pw.z * ps.z, pw.w * ps.w);
        }
        { const int j = tid >> 2, n4 = (tid & 3) * 4;
          *(float4*)&Wn[j][n4] = *(const float4*)(w_out + (size_t)(g * 128 + j) * 1024 + nt * 16 + n4); }
        __syncthreads();
        const int c4 = tid >> 4, n = tid & 15;
        float a0 = 0.f, a1 = 0.f, a2 = 0.f, a3 = 0.f;
#pragma unroll 8
        for (int j = 0; j < 128; j += 4) {
            const float4 p0 = *(const float4*)&P[4 * c4][j], p1 = *(const float4*)&P[4 * c4 + 1][j], p2 = *(const float4*)&P[4 * c4 + 2][j], p3 = *(const float4*)&P[4 * c4 + 3][j];
            const float w0 = Wn[j][n], w1 = Wn[j + 1][n], w2 = Wn[j + 2][n], w3 = Wn[j + 3][n];
            a0 = fmaf(p0.x, w0, a0); a0 = fmaf(p0.y, w1, a0); a0 = fmaf(p0.z, w2, a0); a0 = fmaf(p0.w, w3, a0);
            a1 = fmaf(p1.x, w0, a1); a1 = fmaf(p1.y, w1, a1); a1 = fmaf(p1.z, w2, a1); a1 = fmaf(p1.w, w3, a1);
            a2 = fmaf(p2.x, w0, a2); a2 = fmaf(p2.y, w1, a2); a2 = fmaf(p2.z, w2, a2); a2 = fmaf(p2.w, w3, a2);
            a3 = fmaf(p3.x, w0, a3); a3 = fmaf(p3.y, w1, a3); a3 = fmaf(p3.z, w2, a3); a3 = fmaf(p3.w, w3, a3);
        }
        *(uint2*)(wt_out + (size_t)(nt * 16 + n) * 1024 + g * 128 + 4 * c4) = make_uint2((unsigned)f2bf(a0) | ((unsigned)f2bf(a1) << 16), (unsigned)f2bf(a2) | ((unsigned)f2bf(a3) << 16));
    }
    __syncthreads();
}
__device__ __forceinline__ void rms2_rows8(int lane, int rb, const bf16_t* __restrict__ proj, const float (&gq)[8], const float (&gk)[8], bf16_t* __restrict__ cqn, bf16_t* __restrict__ ckvn) {
    uint4 vq[8], vk[8];
#pragma unroll
    for (int u = 0; u < 8; ++u) {
        const int r = rb + u;
        vq[u] = make_uint4(0, 0, 0, 0); vk[u] = make_uint4(0, 0, 0, 0);
        if (r < T && lane < 48) vq[u] = *(const uint4*)(proj + (size_t)r * PLD + O_CQ + lane * 8);
        if (lane < 32) vk[u] = *(const uint4*)(proj + (size_t)r * PLD + O_CKV + lane * 8);
    }
#pragma unroll
    for (int u = 0; u < 8; ++u) {
        const int r = rb + u; const bool hasq = r < T;
        float fq[8], fk[8];
        unpack8(vq[u], fq); unpack8(vk[u], fk);
        float sq = 0.f, sk = 0.f;
#pragma unroll
        for (int i = 0; i < 8; ++i) { sq += fq[i] * fq[i]; sk += fk[i] * fk[i]; }
        sq = wave_sum(sq); sk = wave_sum(sk);
        const float rq = rsqrtf(sq / (float)QL + EPS), rk = rsqrtf(sk / (float)KVL + EPS);
#pragma unroll
        for (int i = 0; i < 8; ++i) { fq[i] = fq[i] * rq * gq[i]; fk[i] = fk[i] * rk * gk[i]; }
        if (hasq && lane < 48) *(uint4*)(cqn + (size_t)r * QL + lane * 8) = pack8(fq);
        if (lane < 32) *(uint4*)(ckvn + (size_t)r * KVL + lane * 8) = pack8(fk);
    }
}
__device__ __forceinline__ void ph_pm8(const Ctx& cx, const bf16_t* __restrict__ proj, bf16_t* __restrict__ mixin, const float* __restrict__ g_q, const float* __restrict__ g_kv,
                                       bf16_t* __restrict__ cqn, bf16_t* __restrict__ ckvn) {
    float gq[8], gk[8];
#pragma unroll
    for (int i = 0; i < 8; ++i) { gq[i] = cx.lane < 48 ? g_q[cx.lane * 8 + i] : 0.f; gk[i] = cx.lane < 32 ? g_kv[cx.lane * 8 + i] : 0.f; }
    const int lane = cx.lane, W = 2 << (lane >> 4), hw = W >> 1;
    for (int run = cx.gwave; run < T / 16; run += cx.nwave) {
        const int t0 = run * 16, s0 = t0 & (S - 1);
        const bf16_t* base = proj + (size_t)(t0 - s0) * PLD + lane * 8;
        float sum[8];
#pragma unroll
        for (int i = 0; i < 8; ++i) sum[i] = 0.f;
        {   uint4 v[16];
#pragma unroll
            for (int k = 0; k < 16; ++k) { int j = s0 - hw + k; j = j < 0 ? 0 : (j > S - 1 ? S - 1 : j); v[k] = *(const uint4*)(base + (size_t)j * PLD); }
#pragma unroll
            for (int k = 0; k < 16; ++k) { const int j = s0 - hw + k; const float m = (k < W && j >= 0 && j < S) ? 1.0f : 0.0f; float f[8]; unpack8(v[k], f);
#pragma unroll
                for (int i = 0; i < 8; ++i) sum[i] = fmaf(m, f[i], sum[i]); }
        }
#pragma unroll
        for (int q4 = 0; q4 < 4; ++q4) {
            uint4 cv[4], av[4], sv[4];
#pragma unroll
            for (int u = 0; u < 4; ++u) { const int s = s0 + q4 * 4 + u; int ja = s + hw, js = s - hw; ja = ja > S - 1 ? S - 1 : ja; js = js < 0 ? 0 : js;
                cv[u] = *(const uint4*)(base + (size_t)s * PLD); av[u] = *(const uint4*)(base + (size_t)ja * PLD); sv[u] = *(const uint4*)(base + (size_t)js * PLD); }
#pragma unroll
            for (int u = 0; u < 4; ++u) { const int s = s0 + q4 * 4 + u;
                int lo = s - hw; if (lo < 0) lo = 0;
                int hi = s + hw; if (hi > S) hi = S;
                const float inv = 1.0f / (float)(hi - lo);
                float c[8], o[8]; unpack8(cv[u], c);
#pragma unroll
                for (int i = 0; i < 8; ++i) o[i] = sum[i] * inv - c[i];
                *(uint4*)(mixin + (size_t)(t0 + q4 * 4 + u) * 1024 + lane * 8) = pack8(o);
                const float ma = (s + hw < S) ? 1.0f : 0.0f, ms = (s - hw >= 0) ? 1.0f : 0.0f;
                float fa[8], fs[8]; unpack8(av[u], fa); unpack8(sv[u], fs);
#pragma unroll
                for (int i = 0; i < 8; ++i) sum[i] = fmaf(ma, fa[i], fmaf(-ms, fs[i], sum[i]));
            }
        }
        rms2_rows8(lane, t0, proj, gq, gk, cqn, ckvn); rms2_rows8(lane, t0 + 8, proj, gq, gk, cqn, ckvn);
    }
    for (int rb = T + cx.gwave * 8; rb < TA; rb += cx.nwave * 8) rms2_rows8(lane, rb, proj, gq, gk, cqn, ckvn);
}
__device__ __forceinline__ float sum8(float v) { return sum8_dpp(v); }
__device__ __forceinline__ void ph_kfin(const Ctx& cx, const bf16_t* __restrict__ proj, const float* __restrict__ g_qk_k, const float* __restrict__ rope, bf16_t* __restrict__ Kb) {
    const int lane = cx.lane, kq = lane >> 3, p = lane & 7;
    float gk[8], gr[8];
#pragma unroll
    for (int j = 0; j < 8; ++j) { gk[j] = g_qk_k[8 * p + j]; gr[j] = g_qk_k[64 + 8 * (p & 3) + j]; }
    constexpr int NIT = NB * NH * (SKV / 8);
    for (int it0 = cx.gwave; it0 < NIT; it0 += 4 * cx.nwave) {
        bf16_t* rec[4]; uint4 raw[4], rr[4]; int keyv[4]; bool on[4];
#pragma unroll
        for (int u = 0; u < 4; ++u) {
            const int it = it0 + u * cx.nwave; on[u] = it < NIT; const int itc = on[u] ? it : it0;
            const int bh = itc / (SKV / 8), key = (itc - bh * (SKV / 8)) * 8 + kq, b = bh >> 3;
            keyv[u] = key; rec[u] = Kb + ((size_t)bh * SKV + key) * 96;
            const int trow = key < S ? b * S + key : T + b * CTXL + (key - S);
            raw[u] = *(const uint4*)(rec[u] + 8 * p);
            rr[u] = p < 4 ? *(const uint4*)(proj + (size_t)trow * PLD + O_KR + 8 * p) : make_uint4(0u, 0u, 0u, 0u);
        }
#pragma unroll
        for (int u = 0; u < 4; ++u) {
            const int key = keyv[u]; const bool lat = key < S;
            float x[8], r[8]; unpack8(raw[u], x); unpack8(rr[u], r);
            float ss = 0.f;
#pragma unroll
            for (int j = 0; j < 8; ++j) ss += x[j] * x[j] + r[j] * r[j];
            ss = sum8(ss);
            const float rstd = rsqrtf(ss / 96.0f + EPS);
#pragma unroll
            for (int j = 0; j < 8; ++j) { x[j] *= rstd * gk[j]; r[j] *= rstd * gr[j]; }
            if (lat) {
                const int pos = (p & 2) ? (key & 63) : (key >> 6);
#pragma unroll
                for (int j = 0; j < 8; ++j) {
                    const float2 cs = *(const float2*)(rope + (pos * 8 + j) * 2);
                    const float mine = r[j], other = __shfl_xor(mine, 1);
                    r[j] = (p & 1) ? (mine * cs.x + other * cs.y) : (mine * cs.x - other * cs.y);
                }
            }
            if (on[u]) { *(uint4*)(rec[u] + 8 * p) = pack8(x); if (p < 4) *(uint4*)(rec[u] + 64 + 8 * p) = pack8(r); }
        }
    }
}

#define XB_LAS __attribute__((address_space(3)))
#define XB_TMO      128
#define XB_XCNT(j)  (256  + 64 * (j))
#define XB_XSUB(j)  (1280 + 64 * (j))
#define XB_XGEN(j)  (2304 + 64 * (j))
#define XB_TOP      3328
#define XB_TOPGEN   3392
#define XCD_BAR_WORDS 3456
#define XB_SPIN_CAP (1u << 18)
__device__ __forceinline__ unsigned xb_ld(unsigned* p)              { return __hip_atomic_load(p, __ATOMIC_RELAXED, __HIP_MEMORY_SCOPE_AGENT); }
__device__ __forceinline__ unsigned xb_add(unsigned* p, unsigned v) { return __hip_atomic_fetch_add(p, v, __ATOMIC_RELAXED, __HIP_MEMORY_SCOPE_AGENT); }
__device__ __forceinline__ unsigned xb_xcc_id() { return (unsigned)__builtin_amdgcn_s_getreg((3 << 11) | 20) & 0xFu; }
#define XB_SPIN(cond, bar) do { unsigned _sp = 0; while (cond) { __builtin_amdgcn_s_sleep(1); \
    if ((++_sp & 255u) == 0u) { if (xb_ld(&(bar)[XB_TMO])) break; if (_sp > XB_SPIN_CAP) { atomicAdd(&(bar)[XB_TMO], 1u); break; } } } } while (0)
struct XcdBarrier { unsigned* bar; unsigned x; volatile XB_LAS unsigned* st; };
__device__ __forceinline__ XcdBarrier xcd_barrier_post(unsigned* bar, volatile XB_LAS unsigned* st) {
    XcdBarrier b; b.bar = bar; b.x = xb_xcc_id(); b.st = st;
    if (threadIdx.x == 0) (void)xb_add(&bar[XB_XCNT(b.x)], 1u);
    return b;
}
__device__ __forceinline__ void xcd_barrier_complete(unsigned* bar, unsigned x, unsigned& nloc, unsigned& nx) {
    const unsigned G = gridDim.x * gridDim.y * gridDim.z;
    unsigned sum, cnt, mine, sp = 0u;
    for (;;) {
        sum = 0u; cnt = 0u; mine = 0u;
#pragma unroll
        for (unsigned j = 0; j < 16; ++j) { const unsigned c = xb_ld(&bar[XB_XCNT(j)]); sum += c; cnt += (c > 0u) ? 1u : 0u; mine = (j == x) ? c : mine; }
        if (sum == G) break;
        __builtin_amdgcn_s_sleep(1);
        if ((++sp & 255u) == 0u) { if (xb_ld(&bar[XB_TMO])) break; if (sp > XB_SPIN_CAP) { atomicAdd(&bar[XB_TMO], 1u); break; } }
    }
    nloc = mine > 0u ? mine : 1u; nx = cnt > 0u ? cnt : 1u;
}
struct XbTok { unsigned gen, tg; int role; };
__device__ __forceinline__ XbTok xcd_barrier_arrive(const XcdBarrier& b) {
    asm volatile("s_waitcnt vmcnt(0)" ::: "memory");
    __syncthreads();
    XbTok t; t.gen = 0u; t.tg = 0u; t.role = 0;
    if (threadIdx.x == 0) {
        unsigned* bar = b.bar;
        __builtin_amdgcn_s_waitcnt(0);
        unsigned nloc = b.st[0], nx = b.st[1];
        if (nloc == 0u) { xcd_barrier_complete(bar, b.x, nloc, nx); b.st[0] = nloc; b.st[1] = nx; }
        const unsigned old = xb_add(&bar[XB_XSUB(b.x)], 1u);
        t.gen = old / nloc;
        if (old + 1u == (t.gen + 1u) * nloc) {
            __builtin_amdgcn_fence(__ATOMIC_RELEASE, "agent");
            asm volatile("s_waitcnt vmcnt(0)" ::: "memory");
            const unsigned og = xb_add(&bar[XB_TOP], 1u);
            t.tg = og / nx;
            if (og + 1u == (t.tg + 1u) * nx) { xb_add(&bar[XB_TOPGEN], 1u); t.role = 2; } else t.role = 1;
        }
    }
    return t;
}
__device__ __forceinline__ void xcd_barrier_wait(const XcdBarrier& b, const XbTok& t) {
    if (threadIdx.x == 0) {
        unsigned* bar = b.bar;
        if (t.role != 0) {
            if (t.role == 1) XB_SPIN(xb_ld(&bar[XB_TOPGEN]) == t.tg, bar);
            __builtin_amdgcn_fence(__ATOMIC_ACQUIRE, "agent");
            xb_add(&bar[XB_XGEN(b.x)], 1u);
            asm volatile("s_waitcnt vmcnt(0)" ::: "memory");
        } else {
            XB_SPIN(xb_ld(&bar[XB_XGEN(b.x)]) == t.gen, bar);
            __builtin_amdgcn_fence(__ATOMIC_ACQUIRE, "agent");
            asm volatile("s_waitcnt vmcnt(0)" ::: "memory");
        }
    }
    __syncthreads();
}
__device__ __forceinline__ void xcd_barrier(const XcdBarrier& b) {
    asm volatile("s_waitcnt vmcnt(0)" ::: "memory");
    __syncthreads();
    if (threadIdx.x == 0) {
        unsigned* bar = b.bar;
        __builtin_amdgcn_s_waitcnt(0);
        unsigned nloc = b.st[0], nx = b.st[1];
        if (nloc == 0u) { xcd_barrier_complete(bar, b.x, nloc, nx); b.st[0] = nloc; b.st[1] = nx; }
        const unsigned old = xb_add(&bar[XB_XSUB(b.x)], 1u);
        const unsigned gen = old / nloc;
        if (old + 1u == (gen + 1u) * nloc) {
            __builtin_amdgcn_fence(__ATOMIC_RELEASE, "agent");
            asm volatile("s_waitcnt vmcnt(0)" ::: "memory");
            const unsigned og = xb_add(&bar[XB_TOP], 1u);
            const unsigned tg = og / nx;
            if (og + 1u == (tg + 1u) * nx) xb_add(&bar[XB_TOPGEN], 1u);
            else XB_SPIN(xb_ld(&bar[XB_TOPGEN]) == tg, bar);
            __builtin_amdgcn_fence(__ATOMIC_ACQUIRE, "agent");
            xb_add(&bar[XB_XGEN(b.x)], 1u);
            asm volatile("s_waitcnt vmcnt(0)" ::: "memory");
        } else {
            XB_SPIN(xb_ld(&bar[XB_XGEN(b.x)]) == gen, bar);
            __builtin_amdgcn_fence(__ATOMIC_ACQUIRE, "agent");
            asm volatile("s_waitcnt vmcnt(0)" ::: "memory");
        }
    }
    __syncthreads();
}

__device__ __forceinline__ void ph_mod2(const Ctx& cx, char* lds, const float* __restrict__ c, const float* __restrict__ c_ctx, const float* __restrict__ w_ada,
                                        const float* __restrict__ b_ada, float* __restrict__ mod, float* __restrict__ rope) {
    float* sl = (float*)lds;
    float* red = (float*)(lds + 17 * 1024 * 4);
    const int tid = cx.tid;
    if (blockIdx.x == 0 && tid < 512) { const int pos = tid >> 3, i = tid & 7; const float inv = 1.0f / powf(10000.0f, (float)i / 8.0f); const float a = (float)pos * inv; rope[2 * tid] = cosf(a); rope[2 * tid + 1] = sinf(a); }
    __syncthreads();
    {   float xv[34];
#pragma unroll
        for (int i = 0; i < 34; ++i) { const int e = tid + NTHR * i; xv[i] = (e < 16 * 1024) ? c[e] : c_ctx[e - 16 * 1024]; }
#pragma unroll
        for (int i = 0; i < 34; ++i) sl[tid + NTHR * i] = xv[i] / (1.0f + expf(-xv[i])); }
    __syncthreads();
    const int cg = tid % 6, ks = tid / 6;
    for (int cb = blockIdx.x; cb < 256; cb += gridDim.x) {
        float acc[17][4];
#pragma unroll
        for (int b = 0; b < 17; ++b) { acc[b][0] = 0.f; acc[b][1] = 0.f; acc[b][2] = 0.f; acc[b][3] = 0.f; }
        if (tid < 510) {
            float4 w[13];
#pragma unroll
            for (int i = 0; i < 13; ++i) { const int k = ks + 85 * i; w[i] = (k < 1024) ? *(const float4*)(w_ada + (size_t)k * 6144 + cb * 24 + cg * 4) : make_float4(0.f, 0.f, 0.f, 0.f); }
#pragma unroll
            for (int i = 0; i < 13; ++i) {
                const int k = (ks + 85 * i) & 1023;
#pragma unroll
                for (int b = 0; b < 17; ++b) { const float s = sl[b * 1024 + k]; acc[b][0] = fmaf(s, w[i].x, acc[b][0]); acc[b][1] = fmaf(s, w[i].y, acc[b][1]); acc[b][2] = fmaf(s, w[i].z, acc[b][2]); acc[b][3] = fmaf(s, w[i].w, acc[b][3]); }
            }
        }
#pragma unroll
        for (int rd = 0; rd < 3; ++rd) {
            const int r0 = rd * 6, nr = rd < 2 ? 6 : 5;
            __syncthreads();
            if (tid < 510) {
#pragma unroll
                for (int bb = 0; bb < 6; ++bb) if (bb < nr) *(float4*)(red + ((ks * 6 + cg) * 24 + bb * 4)) = make_float4(acc[r0 + bb][0], acc[r0 + bb][1], acc[r0 + bb][2], acc[r0 + bb][3]);
            }
            __syncthreads();
            if (tid < 6 * nr * 4) {
                const int ocg = tid / (nr * 4), rem = tid % (nr * 4), bb = rem >> 2, j = rem & 3;
                float s = 0.f;
                for (int q = 0; q < 85; ++q) s += red[(q * 6 + ocg) * 24 + bb * 4 + j];
                const int col = cb * 24 + ocg * 4 + j;
                mod[(r0 + bb) * 6144 + col] = s + b_ada[col];
            }
        }
        __syncthreads();
    }
}

__device__ __forceinline__ Ctx make_ctx() {
    Ctx c; int t = threadIdx.x; asm volatile("" : "+v"(t));
    c.tid = t; c.lane = t & 63; c.wib = t >> 6;
    c.gthr = blockIdx.x * NTHR + t; c.nthr = gridDim.x * NTHR;
    c.gwave = blockIdx.x * (NTHR / 64) + c.wib; c.nwave = gridDim.x * (NTHR / 64);
    return c;
}
__global__ void __launch_bounds__(NTHR) mega(Params p) {
    extern __shared__ __attribute__((aligned(16))) char lds[];
    cg::grid_group grid = cg::this_grid();
    Ctx cx = make_ctx();
    const float* x = p.in[0]; const float* c = p.in[1]; const float* ctx = p.in[2]; const float* c_ctx = p.in[3];
    const float* w_ada = p.in[4]; const float* b_ada = p.in[5]; const float* g_norm1 = p.in[6]; const float* w_in = p.in[7];
    const float* pool_w = p.in[8]; const float* pool_scale = p.in[9]; const float* g_q_lora = p.in[10]; const float* w_q_up = p.in[11];
    const float* g_kv_lora = p.in[12]; const float* w_kv_up = p.in[13]; const float* g_qk_q = p.in[14]; const float* g_qk_k = p.in[15];
    const float* w_out = p.in[16]; const float* g_norm2 = p.in[17]; const float* peer_w_q = p.in[18]; const float* sub_keys = p.in[19];
    const float* peer_u = p.in[20]; const float* peer_v = p.in[21];
    float* out = p.out; char* ws = p.ws;
    float* mod = (float*)(ws + WS_MOD);
    float* rope = (float*)(ws + WS_ROPE);
    bf16_t* h1 = (bf16_t*)(ws + WS_H1);
    bf16_t* proj = (bf16_t*)(ws + WS_PROJ);
    bf16_t* pm = (bf16_t*)(ws + WS_PM);
    bf16_t* cqn = (bf16_t*)(ws + WS_CQN);
    bf16_t* ckvn = (bf16_t*)(ws + WS_CKVN);
    bf16_t* kvraw = (bf16_t*)(ws + WS_KVRAW);
    bf16_t* Qb = (bf16_t*)(ws + WS_Q);
    bf16_t* Kb = (bf16_t*)(ws + WS_K);
    bf16_t* Vb = (bf16_t*)(ws + WS_V);
    bf16_t* mixin = (bf16_t*)(ws + WS_MIXIN);
    float* mixf = (float*)(ws + WS_MIXF);
    bf16_t* h2 = (bf16_t*)(ws + WS_H2);
    bf16_t* qp = (bf16_t*)(ws + WS_QP);
    int* eidx = (int*)(ws + WS_EIDX);
    float* gates = (float*)(ws + WS_GATES);

    bf16_t* wt_in = (bf16_t*)(ws + WS_WT_IN);
    bf16_t* wt_q = (bf16_t*)(ws + WS_WT_Q);
    bf16_t* wt_kv = (bf16_t*)(ws + WS_WT_KV);
    bf16_t* wt_out = (bf16_t*)(ws + WS_WT_OUT);
    bf16_t* wt_pq = (bf16_t*)(ws + WS_WT_PQ);
    unsigned char* u8 = (unsigned char*)(ws + WS_U8); unsigned char* v8 = (unsigned char*)(ws + WS_V8);
    float* su = (float*)(ws + WS_SU); float* sv = (float*)(ws + WS_SV);

    volatile XB_LAS unsigned* bst = (volatile XB_LAS unsigned*)(lds + LDS_BYTES - 16);
    if (cx.tid < 4) bst[cx.tid] = 0u;
    __syncthreads();
    volatile int* ctl = (volatile int*)(lds + LDS_BYTES - 32);
    XcdBarrier bar; bar.bar = (unsigned*)(ws + WS_BAR); bar.x = xb_xcc_id(); bar.st = bst;
    if (cx.tid == 0) ctl[0] = (int)xb_add(&bar.bar[XB_XCNT(bar.x)], 1u);

#define BAR_SLICE(k) do { const XbTok tk_ = xcd_barrier_arrive(bar); { Ctx c2_ = make_ctx(); if (c2_.wib != 0) { c2_.gwave = (int)blockIdx.x * 7 + c2_.wib - 1; c2_.nwave = (int)gridDim.x * 7; \
            ph_cvt8n(c2_, peer_u, peer_v, u8, v8, su, sv, (k) * 3584, ((k) + 1) * 3584 < 2 * 16384 ? ((k) + 1) * 3584 : 2 * 16384); } } \
        xcd_barrier_wait(bar, tk_); cx = make_ctx(); } while (0)
    ph_mod2(cx, lds, c, c_ctx, w_ada, b_ada, mod, rope);
    unsigned* wmax = (unsigned*)(ws + WS_BAR) + XCD_BAR_WORDS;
    ph_wt_all(cx, lds, w_in, w_q_up, w_kv_up, w_out, peer_w_q, wt_in, wt_q, wt_kv, wt_out, wt_pq, wmax);
    ph_fold(cx, lds, pool_w, pool_scale, w_out, wt_out);
    if (gridDim.y == 0x7fffu) grid.sync();
    xcd_barrier(bar); cx = make_ctx();
    if (cx.tid == 0) {
        int cntx = 0, below = 0, nxx = 0;
        for (unsigned jx = 0; jx < 16; ++jx) { const int cc = (int)xb_ld(&bar.bar[XB_XCNT(jx)]); if (cc > 0) { ++nxx; if (jx < bar.x) ++below; } if (jx == bar.x) cntx = cc; }
        ctl[1] = cntx > 0 ? cntx : 1; ctl[2] = below; ctl[3] = nxx > 0 ? nxx : 1;
    }
    __syncthreads();
    signed char* wq8 = (signed char*)(ws + WS_PM);
    ph_wq8(cx, wt_pq, wmax, wq8);
    signed char* win8 = (signed char*)(ws + WS_PM + 4 * MB);
    float* hs1 = (float*)(ws + WS_PM + 8 * MB);
    ph_wq8(cx, wt_in, wmax + 1, win8, PLD);
    ph_h1(cx, x, ctx, g_norm1, mod, (signed char*)h1, hs1, wmax + 1);
    BAR_SLICE(0);
    run_gemm_i8(lds, (const signed char*)h1, win8, TA, PLD, D, pg8::EpiI8S{proj, PLD, hs1});
    BAR_SLICE(1);
    ph_pm8(cx, proj, mixin, g_q_lora, g_kv_lora, cqn, ckvn);
    BAR_SLICE(2);
    run_gemm(lds, cqn, wt_q, T, 768, QL, pg8::EpiBf16{Qb, 768});
    run_gemm(lds, ckvn, wt_kv, TA, 1024, KVL, pg8::EpiKV{Kb, Vb}, true);
    BAR_SLICE(3);
    ph_kfin(cx, proj, g_qk_k, rope, Kb);
    BAR_SLICE(4);
    ph_attn_mfma(lds, Qb, Kb, Vb, mixin, g_qk_q, rope);
    BAR_SLICE(5);
    bf16_t* mixb = (bf16_t*)(ws + WS_H1);
    run_gemm(lds, mixin, wt_out, T, D, D, pg8::EpiX1b{x, mod, mixb});
    BAR_SLICE(6);
    unsigned* hqn = (unsigned*)(ws + WS_MIXIN);
    float* hs = (float*)(ws + WS_MIXIN + (size_t)T * 1024);
    ph_h2(cx, x, mixb, mod, g_norm2, out, h2, hqn, hs);
    BAR_SLICE(7);
    run_gemm_i8(lds, (const signed char*)h2, wq8, T, 2048, D, pg8::EpiI8{qp, 2048});
    BAR_SLICE(8);
    tk::ph_topk_mfma(cx, lds, qp, sub_keys, eidx, gates, wmax, hs);
    BAR_SLICE(9);
    float* pa = (float*)(ws + WS_Q);
    float* cbuf = (float*)(ws + WS_PM + (size_t)T * 128 * 4);
    ph_peer_u(cx, __builtin_amdgcn_readfirstlane(ctl[0]), __builtin_amdgcn_readfirstlane(ctl[1]), __builtin_amdgcn_readfirstlane(ctl[2]), __builtin_amdgcn_readfirstlane(ctl[3]), hqn, hs, eidx, u8, pa);
    xcd_barrier(bar); cx = make_ctx();
    ph_peer_r4(cx, lds, pa, eidx, gates, su, (unsigned*)cbuf, cbuf + (size_t)T * 64);
    xcd_barrier(bar); cx = make_ctx();
    ph_peer_v4(cx, lds, __builtin_amdgcn_readfirstlane(ctl[0]), __builtin_amdgcn_readfirstlane(ctl[1]), __builtin_amdgcn_readfirstlane(ctl[2]), __builtin_amdgcn_readfirstlane(ctl[3]), eidx, (const unsigned*)cbuf, cbuf + (size_t)T * 64, v8, mod, x, mixb, out);
}

extern "C" void kernel_launch(void* const* d_in, const int* in_sizes, int n_in, void* d_out, int out_size, void* d_ws, size_t ws_size, hipStream_t stream) {
    static int grid_blocks = 0;
    if (!grid_blocks) {
        int dev = 0, cus = 0, per_cu = 0;
        (void)hipGetDevice(&dev);
        (void)hipDeviceGetAttribute(&cus, hipDeviceAttributeMultiprocessorCount, dev);
        (void)hipFuncSetAttribute((const void*)mega, hipFuncAttributeMaxDynamicSharedMemorySize, LDS_BYTES);
        (void)hipOccupancyMaxActiveBlocksPerMultiprocessor(&per_cu, mega, NTHR, LDS_BYTES);
        if (per_cu < 1) per_cu = 1;
        grid_blocks = cus * per_cu;
        if (ws_size < WS_END2) fprintf(stderr, "kernel_launch: workspace too small: %zu < %zu\n", ws_size, (size_t)WS_END2);
    }
    (void)hipMemsetAsync((char*)d_ws + WS_BAR, 0, XCD_BAR_WORDS * 4 + 64, stream);
    Params p{};
    for (int i = 0; i < 22; ++i) p.in[i] = (const float*)d_in[i];
    p.out = (float*)d_out; p.ws = (char*)d_ws;
    void* args[] = {&p};
    hipError_t e = hipLaunchCooperativeKernel((const void*)mega, dim3(grid_blocks), dim3(NTHR), args, LDS_BYTES, stream);
    if (e != hipSuccess) fprintf(stderr, "cooperative launch failed: %s (grid %d)\n", hipGetErrorString(e), grid_blocks);
}
```
